# Optimizing an MI355X kernel written in HIP

```python
import math
import jax
import jax.numpy as jnp
from jax import lax
import numpy as np

D_MODEL = 1024
BATCH = 16
SEQ = 2048
DEPTH = 4

GRID_W = 64
CTX_LEN = 256
N_GROUPS = 4
HEADS = 4
HEAD_DIM = D_MODEL // (N_GROUPS * HEADS)
MIX_WIDTH = N_GROUPS * HEADS * HEAD_DIM
NA_WIN_R = 8
NA_WIN_C = 16
MLA_Q_LORA = 3 * D_MODEL // 16
MLA_KV_LORA = D_MODEL // 8
MLA_NOPE = HEAD_DIM
MLA_ROPE = HEAD_DIM // 2
MLA_V = HEAD_DIM
SWA_HKV = 2
SWA_GROUP = HEADS // SWA_HKV
SWA_WINDOW = 128
DIFF_DH = HEAD_DIM // 2
D_FF = 4 * D_MODEL
BLK = 128
ROPE_BASE = 10000.0
EPS = 1e-6
NEG_INF = -1e30
IN_SIZES = (
    HEADS * HEAD_DIM, HEADS * HEAD_DIM, HEADS * HEAD_DIM,
    MLA_Q_LORA, MLA_KV_LORA, MLA_ROPE,
    HEADS * HEAD_DIM, SWA_HKV * HEAD_DIM, SWA_HKV * HEAD_DIM,
    HEADS * 2 * DIFF_DH, HEADS * 2 * DIFF_DH, HEADS * HEAD_DIM,
)
IN_COLS = sum(IN_SIZES)

kernel_name = 'hybrid_parallel_heads_dit_block'


def rmsnorm(x, g):
    xf = x.astype(jnp.float32)
    y = xf * lax.rsqrt(jnp.mean(xf * xf, axis=-1, keepdims=True) + EPS)
    return (y * g.astype(jnp.float32)).astype(x.dtype)


def modulate(h, shift, scale):
    return h * (1 + scale) + shift


def split_heads(t, n):
    return t.reshape(t.shape[:-1] + (n, t.shape[-1] // n))


def split_cols(z):
    parts, start = [], 0
    for size in IN_SIZES:
        parts.append(z[..., start:start + size])
        start += size
    return parts


def softmax_f32(s):
    return jax.nn.softmax(s.astype(jnp.float32), axis=-1)


def axial_rope(row, col, dim):
    n_freq = dim // 4
    freqs = ROPE_BASE ** (-jnp.arange(n_freq, dtype=jnp.float32) / n_freq)
    ang = jnp.concatenate([row.astype(jnp.float32)[:, None] * freqs,
                           col.astype(jnp.float32)[:, None] * freqs], axis=-1)
    return jnp.cos(ang), jnp.sin(ang)


def apply_rope(x, rope):
    cos, sin = rope
    cos = cos[:, None, :].astype(x.dtype)
    sin = sin[:, None, :].astype(x.dtype)
    half = x.shape[-1] // 2
    x1, x2 = x[..., :half], x[..., half:]
    return jnp.concatenate([x1 * cos - x2 * sin, x1 * sin + x2 * cos], axis=-1)


def sweep_query_blocks(fn, q):
    B, L = q.shape[:2]
    qb = jnp.moveaxis(q.reshape((B, L // BLK, BLK) + q.shape[2:]), 1, 0)
    o = lax.map(fn, qb)
    return jnp.moveaxis(o, 0, 1).reshape((B, L) + o.shape[3:])


def attend(q, k, v, scale):
    s = jnp.einsum('bqhd,bkhd->bhqk', q, k).astype(jnp.float32) * scale
    p = softmax_f32(s).astype(v.dtype)
    return jnp.einsum('bhqk,bkhd->bqhd', p, v)


def neighbourhood_attention(zl, zc, rpb, need_ctx):
    q, k, v = (split_heads(t, HEADS) for t in zl)
    qc, kc, vc = (split_heads(t, HEADS) for t in zc)
    B, S = q.shape[:2]
    rows_n = S // GRID_W
    kr_n = min(NA_WIN_R, rows_n)
    n_loc = kr_n * GRID_W
    scale = HEAD_DIM ** -0.5
    qg = q.reshape(B, rows_n, GRID_W, HEADS, HEAD_DIM)
    kg = k.reshape(B, rows_n, GRID_W, HEADS, HEAD_DIM)
    vg = v.reshape(B, rows_n, GRID_W, HEADS, HEAD_DIM)
    col = jnp.arange(GRID_W)
    c0 = jnp.clip(col - NA_WIN_C // 2, 0, GRID_W - NA_WIN_C)
    col_ok = (col[None, :] >= c0[:, None]) & (col[None, :] < c0[:, None] + NA_WIN_C)
    dc_idx = jnp.clip(col[None, :] - col[:, None], 1 - NA_WIN_C, NA_WIN_C - 1) + (NA_WIN_C - 1)

    def row_block(r):
        r0 = jnp.clip(r - kr_n // 2, 0, rows_n - kr_n)
        q_r = lax.dynamic_index_in_dim(qg, r, axis=1, keepdims=False)
        k_r = lax.dynamic_slice_in_dim(kg, r0, kr_n, axis=1).reshape(B, n_loc, HEADS, HEAD_DIM)
        v_r = lax.dynamic_slice_in_dim(vg, r0, kr_n, axis=1).reshape(B, n_loc, HEADS, HEAD_DIM)
        dr_idx = r0 + jnp.arange(kr_n) - r + (NA_WIN_R - 1)
        bias = rpb[:, dr_idx[None, :, None], dc_idx[:, None, :]].astype(jnp.float32)
        bias = jnp.where(col_ok[None, :, None, :], bias, NEG_INF).reshape(HEADS, GRID_W, n_loc)
        s_loc = jnp.einsum('bqhd,bkhd->bhqk', q_r, k_r).astype(jnp.float32) * scale + bias
        s_ctx = jnp.einsum('bqhd,bchd->bhqc', q_r, kc).astype(jnp.float32) * scale
        p = softmax_f32(jnp.concatenate([s_loc, s_ctx], axis=-1)).astype(v.dtype)
        return (jnp.einsum('bhqk,bkhd->bqhd', p[..., :n_loc], v_r)
                + jnp.einsum('bhqc,bchd->bqhd', p[..., n_loc:], vc))

    o = lax.map(row_block, jnp.arange(rows_n))
    o_lat = jnp.moveaxis(o, 0, 1).reshape(B, S, HEADS * HEAD_DIM)
    o_ctx = attend(qc, kc, vc, scale).reshape(B, -1, HEADS * HEAD_DIM) if need_ctx else None
    return o_lat, o_ctx


def mla_project(cq, ckv, kr, gq, w_uq, gkv, w_ukv, rope):
    q = split_heads(rmsnorm(cq, gq) @ w_uq, HEADS)
    kv = split_heads(rmsnorm(ckv, gkv) @ w_ukv, HEADS)
    q_nope, q_rope = q[..., :MLA_NOPE], q[..., MLA_NOPE:]
    k_nope, v = kv[..., :MLA_NOPE], kv[..., MLA_NOPE:]
    k_rope = kr[:, :, None, :]
    if rope is not None:
        q_rope = apply_rope(q_rope, rope)
        k_rope = apply_rope(k_rope, rope)
    q = jnp.concatenate([q_nope, q_rope], axis=-1)
    k = jnp.concatenate([k_nope, jnp.broadcast_to(k_rope, k_nope.shape[:-1] + (MLA_ROPE,))], axis=-1)
    return q, k, v


def latent_attention(zl, zc, gq, w_uq, gkv, w_ukv, rope, need_ctx):
    B, S = zl[0].shape[:2]
    ql, kl, vl = mla_project(zl[0], zl[1], zl[2], gq, w_uq, gkv, w_ukv, rope)
    qc, kc, vc = mla_project(zc[0], zc[1], zc[2], gq, w_uq, gkv, w_ukv, None)
    scale = (MLA_NOPE + MLA_ROPE) ** -0.5
    k_all = jnp.concatenate([kl, kc], axis=1)
    v_all = jnp.concatenate([vl, vc], axis=1)
    o_lat = sweep_query_blocks(lambda qi: attend(qi, k_all, v_all, scale), ql).reshape(B, S, HEADS * MLA_V)
    o_ctx = attend(qc, kc, vc, scale).reshape(B, -1, HEADS * MLA_V) if need_ctx else None
    return o_lat, o_ctx


def window_attention(zl, zc, sink, rope, need_ctx):
    B, S = zl[0].shape[:2]
    C = zc[0].shape[1]
    ql = apply_rope(split_heads(zl[0], HEADS), rope)
    kl = apply_rope(split_heads(zl[1], SWA_HKV), rope)
    vl = split_heads(zl[2], SWA_HKV)
    qc = zc[0].reshape(B, C, SWA_HKV, SWA_GROUP, HEAD_DIM)
    kc = split_heads(zc[1], SWA_HKV)
    vc = split_heads(zc[2], SWA_HKV)
    scale = HEAD_DIM ** -0.5
    sink_hg = sink.astype(jnp.float32).reshape(SWA_HKV, SWA_GROUP)
    pad = ((0, 0), (BLK, BLK), (0, 0), (0, 0))
    kp = jnp.pad(kl, pad)
    vp = jnp.pad(vl, pad)

    def band_block(i):
        q_i = lax.dynamic_slice_in_dim(ql, i * BLK, BLK, axis=1).reshape(B, BLK, SWA_HKV, SWA_GROUP, HEAD_DIM)
        k_i = lax.dynamic_slice_in_dim(kp, i * BLK, 3 * BLK, axis=1)
        v_i = lax.dynamic_slice_in_dim(vp, i * BLK, 3 * BLK, axis=1)
        qpos = i * BLK + jnp.arange(BLK)
        kpos = i * BLK - BLK + jnp.arange(3 * BLK)
        valid = ((jnp.abs(kpos[None, :] - qpos[:, None]) <= SWA_WINDOW)
                 & (kpos >= 0)[None, :] & (kpos < S)[None, :])
        s_loc = jnp.einsum('bqhgd,bkhd->bhgqk', q_i, k_i).astype(jnp.float32) * scale
        s_loc = jnp.where(valid, s_loc, NEG_INF)
        s_ctx = jnp.einsum('bqhgd,bchd->bhgqc', q_i, kc).astype(jnp.float32) * scale
        s_sink = jnp.broadcast_to(sink_hg[None, :, :, None, None], (B, SWA_HKV, SWA_GROUP, BLK, 1))
        p = softmax_f32(jnp.concatenate([s_loc, s_ctx, s_sink], axis=-1)).astype(vl.dtype)
        o = (jnp.einsum('bhgqk,bkhd->bqhgd', p[..., :3 * BLK], v_i)
             + jnp.einsum('bhgqc,bchd->bqhgd', p[..., 3 * BLK:3 * BLK + C], vc))
        return o.reshape(B, BLK, HEADS * HEAD_DIM)

    o = lax.map(band_block, jnp.arange(S // BLK))
    o_lat = jnp.moveaxis(o, 0, 1).reshape(B, S, HEADS * HEAD_DIM)
    o_ctx = None
    if need_ctx:
        s = jnp.einsum('bqhgd,bkhd->bhgqk', qc, kc).astype(jnp.float32) * scale
        s_sink = jnp.broadcast_to(sink_hg[None, :, :, None, None], (B, SWA_HKV, SWA_GROUP, C, 1))
        p = softmax_f32(jnp.concatenate([s, s_sink], axis=-1))[..., :C].astype(vc.dtype)
        o_ctx = jnp.einsum('bhgqk,bkhd->bqhgd', p, vc).reshape(B, C, HEADS * HEAD_DIM)
    return o_lat, o_ctx


def differential_attention(zl, zc, lam_params, norm_g, lam_init, rope, need_ctx):
    B, S = zl[0].shape[:2]
    C = zc[0].shape[1]
    ql = apply_rope(split_heads(zl[0], 2 * HEADS), rope).reshape(B, S, HEADS, 2, DIFF_DH)
    kl = apply_rope(split_heads(zl[1], 2 * HEADS), rope).reshape(B, S, HEADS, 2, DIFF_DH)
    vl = split_heads(zl[2], HEADS)
    qc = zc[0].reshape(B, C, HEADS, 2, DIFF_DH)
    kc = zc[1].reshape(B, C, HEADS, 2, DIFF_DH)
    vc = split_heads(zc[2], HEADS)
    lp = lam_params.astype(jnp.float32)
    lam = jnp.exp(jnp.sum(lp[0] * lp[1])) - jnp.exp(jnp.sum(lp[2] * lp[3])) + lam_init
    scale = DIFF_DH ** -0.5
    k_all = jnp.concatenate([kl, kc], axis=1)
    v_all = jnp.concatenate([vl, vc], axis=1)

    def diff_attend(q, k, v):
        s = jnp.einsum('bqhtd,bkhtd->bhtqk', q, k).astype(jnp.float32) * scale
        p = softmax_f32(s)
        a = (p[:, :, 0] - lam * p[:, :, 1]).astype(v.dtype)
        o = jnp.einsum('bhqk,bkhd->bqhd', a, v)
        return rmsnorm(o, norm_g) * (1.0 - lam_init)

    o_lat = sweep_query_blocks(lambda qi: diff_attend(qi, k_all, v_all), ql).reshape(B, S, HEADS * HEAD_DIM)
    o_ctx = diff_attend(qc, kc, vc).reshape(B, C, HEADS * HEAD_DIM) if need_ctx else None
    return o_lat, o_ctx


def sq_relu_mlp(h, w_up, w_down):
    return jnp.square(jax.nn.relu(h @ w_up)) @ w_down


def setup_inputs(seed: int = 0) -> dict:
    key = jax.random.key(seed)
    ks = jax.random.split(key, 21)
    f32 = jnp.float32

    def nrm(k, shape, scale):
        return jax.random.normal(k, shape, f32) * scale

    def gain(k, shape):
        return 1.0 + 0.05 * jax.random.normal(k, shape, f32)

    return {
        'x': nrm(ks[0], (BATCH, SEQ, D_MODEL), 1.0),
        'c': nrm(ks[1], (BATCH, D_MODEL), 1.0),
        'ctx': nrm(ks[2], (BATCH, CTX_LEN, D_MODEL), 1.0),
        'c_ctx': nrm(ks[3], (D_MODEL,), 1.0),
        'w_ada': nrm(ks[4], (DEPTH, D_MODEL, 6 * D_MODEL), 0.5 * D_MODEL ** -0.5),
        'b_ada': nrm(ks[5], (DEPTH, 6 * D_MODEL), 0.02),
        'norm_attn_g': gain(ks[6], (DEPTH, D_MODEL)),
        'w_in': nrm(ks[7], (DEPTH, D_MODEL, IN_COLS), D_MODEL ** -0.5),
        'na_rpb': nrm(ks[8], (DEPTH, HEADS, 2 * NA_WIN_R - 1, 2 * NA_WIN_C - 1), 0.1),
        'mla_q_norm_g': gain(ks[9], (DEPTH, MLA_Q_LORA)),
        'mla_w_uq': nrm(ks[10], (DEPTH, MLA_Q_LORA, HEADS * (MLA_NOPE + MLA_ROPE)), MLA_Q_LORA ** -0.5),
        'mla_kv_norm_g': gain(ks[11], (DEPTH, MLA_KV_LORA)),
        'mla_w_ukv': nrm(ks[12], (DEPTH, MLA_KV_LORA, HEADS * (MLA_NOPE + MLA_V)), MLA_KV_LORA ** -0.5),
        'swa_sink': nrm(ks[13], (DEPTH, HEADS), 0.5),
        'diff_lambda': nrm(ks[14], (DEPTH, 4, DIFF_DH), 0.1),
        'diff_norm_g': gain(ks[15], (DEPTH, HEAD_DIM)),
        'w_out': nrm(ks[16], (DEPTH, MIX_WIDTH, D_MODEL), MIX_WIDTH ** -0.5),
        'norm_mlp_g': gain(ks[17], (DEPTH, D_MODEL)),
        'w_up': nrm(ks[18], (DEPTH, D_MODEL, D_FF), D_MODEL ** -0.5),
        'w_down': nrm(ks[19], (DEPTH, D_FF, D_MODEL), D_FF ** -0.5),
        'final_norm_g': gain(ks[20], (D_MODEL,)),
    }


def reference(x, c, ctx, c_ctx, w_ada, b_ada, norm_attn_g, w_in, na_rpb, mla_q_norm_g, mla_w_uq,
              mla_kv_norm_g, mla_w_ukv, swa_sink, diff_lambda, diff_norm_g, w_out, norm_mlp_g,
              w_up, w_down, final_norm_g):
    S = x.shape[1]
    t = jnp.arange(S)
    row, col = t // GRID_W, t % GRID_W
    rope64 = axial_rope(row, col, HEAD_DIM)
    rope32 = axial_rope(row, col, MLA_ROPE)
    c_act = jax.nn.silu(c)
    cc_act = jax.nn.silu(c_ctx)
    xl, xc = x, ctx
    for l in range(DEPTH):
        need_ctx = l < DEPTH - 1
        lam_init = 0.8 - 0.6 * math.exp(-0.3 * l)
        mod_l = jnp.split((c_act @ w_ada[l] + b_ada[l])[:, None, :], 6, axis=-1)
        mod_c = jnp.split(cc_act @ w_ada[l] + b_ada[l], 6, axis=-1)
        hl = modulate(rmsnorm(xl, norm_attn_g[l]), mod_l[0], mod_l[1])
        hc = modulate(rmsnorm(xc, norm_attn_g[l]), mod_c[0], mod_c[1])
        zl = split_cols(hl @ w_in[l])
        zc = split_cols(hc @ w_in[l])
        oa_l, oa_c = neighbourhood_attention(zl[0:3], zc[0:3], na_rpb[l], need_ctx)
        ob_l, ob_c = latent_attention(zl[3:6], zc[3:6], mla_q_norm_g[l], mla_w_uq[l],
                                      mla_kv_norm_g[l], mla_w_ukv[l], rope32, need_ctx)
        oc_l, oc_c = window_attention(zl[6:9], zc[6:9], swa_sink[l], rope64, need_ctx)
        od_l, od_c = differential_attention(zl[9:12], zc[9:12], diff_lambda[l], diff_norm_g[l],
                                            lam_init, rope32, need_ctx)
        mix_l = jnp.concatenate([oa_l, ob_l, oc_l, od_l], axis=-1)
        xl = xl + mod_l[2] * (mix_l @ w_out[l])
        hl = modulate(rmsnorm(xl, norm_mlp_g[l]), mod_l[3], mod_l[4])
        xl = xl + mod_l[5] * sq_relu_mlp(hl, w_up[l], w_down[l])
        if need_ctx:
            mix_c = jnp.concatenate([oa_c, ob_c, oc_c, od_c], axis=-1)
            xc = xc + mod_c[2] * (mix_c @ w_out[l])
            hc = modulate(rmsnorm(xc, norm_mlp_g[l]), mod_c[3], mod_c[4])
            xc = xc + mod_c[5] * sq_relu_mlp(hc, w_up[l], w_down[l])
    return rmsnorm(xl, final_norm_g)
```

```cpp
#include <hip/hip_runtime.h>
#include <hip/hip_cooperative_groups.h>
#include <cstdio>
#include <cstdint>
#include <cmath>
namespace cg = cooperative_groups;

#define LAS __attribute__((address_space(3)))
#define GAS __attribute__((address_space(1)))
typedef unsigned short bf16_t;
typedef short bf16x8 __attribute__((ext_vector_type(8)));
typedef short s16x4 __attribute__((ext_vector_type(4)));
typedef float f32x4 __attribute__((ext_vector_type(4)));
typedef float f32x16 __attribute__((ext_vector_type(16)));
typedef unsigned u32x4 __attribute__((ext_vector_type(4)));
typedef unsigned u32x2 __attribute__((ext_vector_type(2)));

template <class T> __device__ __forceinline__ T gld(const void* p) { return *(const GAS T*)p; }
template <class T> __device__ __forceinline__ void gst(void* p, T v) { *(GAS T*)p = v; }
template <class T> __device__ __forceinline__ T gld_nt(const void* p) { return __builtin_nontemporal_load((const GAS T*)p); }
template <class T> __device__ __forceinline__ void gst_nt(void* p, T v) { __builtin_nontemporal_store(v, (GAS T*)p); }

constexpr int DM = 1024, NB = 16, SEQ = 2048, DEPTH = 4, CTX = 256, DFF = 4096;
constexpr int NLAT = NB * SEQ;
constexpr int NCTX = NB * CTX;
constexpr int MROWS = NLAT + NCTX;
constexpr int INC = 2400;
constexpr int NZ = 2560;
constexpr float EPS = 1e-6f;
constexpr float LOG2E = 1.4426950408889634f;
constexpr float NEGBIG = -1e30f;
constexpr int Z_NAQ = 0, Z_NAK = 256, Z_NAV = 512, Z_SWQ = 768, Z_SWK = 1024, Z_SWV = 1152, Z_DFQ = 1280, Z_DFK = 1536, Z_DFV = 1792,
              Z_CQ = 2048, Z_CKV = 2304, Z_KR = 2432;

constexpr size_t MiB = 1u << 20;
constexpr size_t WS_MOD = 0, WS_ROPE = 2 * MiB, WS_LAM = 3 * MiB, WS_WIN = 4 * MiB, WS_WOUT = 24 * MiB, WS_WUP = 32 * MiB, WS_WDOWN = 64 * MiB,
                 WS_WUQ = 96 * MiB, WS_WUKV = 97 * MiB, WS_XC = 98 * MiB, WS_H = 114 * MiB, WS_Z = 186 * MiB, WS_QM = 366 * MiB, WS_KM = 393 * MiB,
                 WS_VM = 411 * MiB, WS_MIX = 429 * MiB, WS_U = 186 * MiB, WS_END = 501 * MiB;
constexpr size_t WS_SSQ = WS_LAM + 4096;
constexpr size_t WS_PART = 474 * MiB;
constexpr size_t WS_BAR = WS_LAM + 512 * 1024;
constexpr int LDS_BYTES = 147456;

typedef float f32x2_c __attribute__((ext_vector_type(2))); typedef __bf16 bf16x2_c __attribute__((ext_vector_type(2)));
__device__ __forceinline__ unsigned cvt_pk_bf16(float lo, float hi) { f32x2_c v = {lo, hi}; bf16x2_c b = __builtin_convertvector(v, bf16x2_c); return __builtin_bit_cast(unsigned, b); }
__device__ __forceinline__ int opq_s(int x) { asm volatile("" : "+s"(x)); return x; }
__device__ __forceinline__ int opq_v(int x) { asm volatile("" : "+v"(x)); return x; }
__device__ __forceinline__ int fresh_lane() { int z = 0; asm volatile("" : "+v"(z)); return (int)__builtin_amdgcn_mbcnt_hi(~0u, __builtin_amdgcn_mbcnt_lo(~0u, (unsigned)z)); }
__device__ __forceinline__ int fresh_tid(int wv) { return wv * 64 + fresh_lane(); }
__device__ __forceinline__ unsigned char* opq_p(unsigned char* p) { asm volatile("" : "+s"(p)); return p; }
__device__ __forceinline__ float max3f(float a, float b, float c) { float r; asm("v_max3_f32 %0, %1, %2, %3" : "=v"(r) : "v"(a), "v"(b), "v"(c)); return r; }
__device__ __forceinline__ float max2f(float a, float b) { float r; asm("v_max_f32_e32 %0, %1, %2" : "=v"(r) : "v"(a), "v"(b)); return r; }
__device__ __forceinline__ float xhalf_max(float m) { auto rr = __builtin_amdgcn_permlane32_swap(__float_as_uint(m), __float_as_uint(m), false, false); return fmaxf(__uint_as_float(rr[0]), __uint_as_float(rr[1])); }
__device__ __forceinline__ float xhalf_sum(float m) { auto rr = __builtin_amdgcn_permlane32_swap(__float_as_uint(m), __float_as_uint(m), false, false); return __uint_as_float(rr[0]) + __uint_as_float(rr[1]); }
template <int X> __device__ __forceinline__ float swz_xor(float v) { return __int_as_float(__builtin_amdgcn_ds_swizzle(__float_as_int(v), (X << 10) | 0x1f)); }
__device__ __forceinline__ float bf_lo(unsigned w) { return __uint_as_float(w << 16); }
__device__ __forceinline__ float bf_hi(unsigned w) { return __uint_as_float(w & 0xffff0000u); }

namespace pg8 {
constexpr int BM = 256, BK = 64, HALF = 128, HTB = HALF * BK * 2, STAGE_BYTES = 8 * HTB, NXCD = 8, WGM = 8;
__host__ __device__ __forceinline__ int lds_byte(int r, int c) { const int st = (r >> 4) * 2 + (c >> 5), rr = r & 15, cc = c & 31, ob = rr * 64 + cc * 2; return st * 1024 + (ob ^ (((ob >> 9) & 1) << 5)); }
__host__ __device__ __forceinline__ void stage_rc(int b, int& R, int& C) { const int st = b / 1024, sb = b % 1024, swz = sb ^ (((sb >> 9) & 1) << 5); R = (st >> 1) * 16 + swz / 64; C = (st & 1) * 32 + (swz % 64) / 2; }
__host__ __device__ __forceinline__ int perm32(int rho) { const int n = rho >> 4, i = rho & 15; return 8 * (i >> 2) + 4 * n + (i & 3); }
struct Unit { int pm, pn; };
struct Gemm { const bf16_t* A; const bf16_t* Bt; int M, N, K, lda, ldb; int ks_rt; };
struct StaticOrder {
    int nM, nN, nwg, G, c;
    __device__ void init(int M, int N, int G_, int c_) { nM = M / BM; nN = N / BM; nwg = nM * nN; G = G_; c = c_; }
    __device__ bool next(int i, Unit& u) const {
        const long L = (long)i * G + c; if (L >= nwg) return false;
        int wgid = (int)L; { const int q = nwg / NXCD, r = nwg % NXCD, xcd = wgid % NXCD, off = wgid / NXCD; wgid = (xcd < r ? xcd * (q + 1) : r * (q + 1) + (xcd - r) * q) + off; }
        const int nig = WGM * nN, gid = wgid / nig, fm = gid * WGM, gsz = (nM - fm) < WGM ? (nM - fm) : WGM;
        u.pm = fm + ((wgid % nig) % gsz); u.pn = (wgid % nig) / gsz; return true;
    }
};
template <class Epi>
__device__ __forceinline__ void gemm_phase(LAS unsigned char* lds, const Gemm g, const StaticOrder& S, const Epi& E, const int wv) {
    const int tid = fresh_tid(wv), wid = wv, lane = tid & 63, wr = wid >> 2, wc = wid & 3, fr = lane & 15, fq = lane >> 4;
    const int K = opq_s(g.K), nt = K / BK;
    unsigned voffA[2], voffB[2];
#pragma unroll
    for (int i = 0; i < 2; ++i) { int R, C; stage_rc(tid * 16 + i * 8192, R, C); const int Rb = Epi::PERM ? ((R & ~31) + perm32(R & 31)) : R;
        voffA[i] = (unsigned)(R * g.lda + C) * 2u; voffB[i] = (unsigned)(Rb * g.ldb + C) * 2u; }
    const size_t kstep = (size_t)(BK * 2);
    const size_t hstepA = (size_t)HALF * g.lda * 2, hstepB = (size_t)HALF * g.ldb * 2;
    const size_t tstepA = 2 * hstepA, tstepB = 2 * hstepB;
    const unsigned ldsw = (unsigned)wid * 1024u;
    const int aoff = lds_byte(wr * 64 + fr, fq * 8), boff = lds_byte(wc * 32 + fr, fq * 8);
#define PG8_SA(b, h) (((b) * 2 + (h)) * HTB)
#define PG8_SB(b, h) ((4 + (b) * 2 + (h)) * HTB)
#define PG8_STAGE(bufoff, gbase, voff) do { _Pragma("unroll") for (int _i = 0; _i < 2; ++_i) \
        __builtin_amdgcn_global_load_lds((const unsigned*)((const char*)(gbase) + (voff)[_i]), (LAS unsigned*)(lds + (bufoff) + ldsw + _i * 8192), 16, 0, 0); } while (0)
#define PG8_LDA(dst, b, h) do { _Pragma("unroll") for (int m = 0; m < 4; ++m) _Pragma("unroll") for (int k = 0; k < 2; ++k) dst[m][k] = *(const LAS bf16x8*)(lds + PG8_SA(b, h) + aoff + m * 2048 + k * 1024); } while (0)
#define PG8_LDB(dst, b, h) do { _Pragma("unroll") for (int n = 0; n < 2; ++n) _Pragma("unroll") for (int k = 0; k < 2; ++k) dst[n][k] = *(const LAS bf16x8*)(lds + PG8_SB(b, h) + boff + n * 2048 + k * 1024); } while (0)
#define PG8_MMA(ai, bj, At, Bt) do { __builtin_amdgcn_s_setprio(1); _Pragma("unroll") for (int m = 0; m < 4; ++m) _Pragma("unroll") for (int n = 0; n < 2; ++n) _Pragma("unroll") for (int k = 0; k < 2; ++k) \
        acc[ai][bj][m][n] = __builtin_amdgcn_mfma_f32_16x16x32_bf16(Bt[n][k], At[m][k], acc[ai][bj][m][n], 0, 0, 0); __builtin_amdgcn_s_setprio(0); } while (0)
#define PG8_WAIT_V(n) asm volatile("s_waitcnt vmcnt(" #n ")" ::: "memory")
#define PG8_WAIT_L(n) asm volatile("s_waitcnt lgkmcnt(" #n ")" ::: "memory")
#define PG8_BAR __builtin_amdgcn_s_barrier()
#define PG8_SCHED __builtin_amdgcn_sched_barrier(0)
    Unit cur, nxt; int ui = 0;
    if (!S.next(0, cur)) return;
    f32x4 acc[2][2][4][2];
#pragma unroll
    for (int a = 0; a < 2; ++a)
#pragma unroll
        for (int b = 0; b < 2; ++b)
#pragma unroll
            for (int m = 0; m < 4; ++m)
#pragma unroll
                for (int n = 0; n < 2; ++n) acc[a][b][m][n] = (f32x4){0.f, 0.f, 0.f, 0.f};
    bf16x8 At[4][2], B0[2][2], B1[2][2];
#define PG8_ABASE(u) ((const char*)g.A + (g.ks_rt ? (size_t)((u).pm % g.ks_rt) * tstepA + (size_t)((u).pm / g.ks_rt) * K * 2 : (size_t)(u).pm * tstepA))
#define PG8_BBASE(u) ((const char*)g.Bt + (size_t)(u).pn * tstepB + (g.ks_rt ? (size_t)((u).pm / g.ks_rt) * K * 2 : (size_t)0))
    const char* cA = PG8_ABASE(cur); const char* cB = PG8_BBASE(cur);
    PG8_STAGE(PG8_SB(0, 0), cB, voffB); PG8_STAGE(PG8_SB(0, 1), cB + hstepB, voffB); PG8_STAGE(PG8_SA(0, 0), cA, voffA); PG8_STAGE(PG8_SA(0, 1), cA + hstepA, voffA);
    if (wr == 1) PG8_BAR;
    PG8_WAIT_V(2); PG8_BAR;
    PG8_STAGE(PG8_SB(1, 0), cB + kstep, voffB); PG8_STAGE(PG8_SA(1, 0), cA + kstep, voffA); PG8_STAGE(PG8_SB(1, 1), cB + hstepB + kstep, voffB);
    PG8_WAIT_V(6); PG8_BAR;
    for (;;) {
        const bool has_next = S.next(ui + 1, nxt);
        const char* nA = has_next ? PG8_ABASE(nxt) : cA; const char* nB = has_next ? PG8_BBASE(nxt) : cB;
        for (int t = 0; t < nt; t += 2) {
            const bool last = (t == nt - 2);
            const char* a1 = cA + (size_t)(t + 1) * kstep;
            const char* a2 = last ? nA : cA + (size_t)(t + 2) * kstep; const char* b2 = last ? nB : cB + (size_t)(t + 2) * kstep;
            const char* a3 = a2 + kstep; const char* b3 = b2 + kstep;
            PG8_LDB(B0, 0, 0); PG8_LDB(B1, 0, 1); PG8_SCHED; PG8_LDA(At, 0, 0); PG8_STAGE(PG8_SA(1, 1), a1 + hstepA, voffA);
            PG8_WAIT_V(8); PG8_WAIT_L(0); PG8_BAR; PG8_MMA(0, 0, At, B0); PG8_MMA(0, 1, At, B1); PG8_BAR; PG8_SCHED;
            PG8_LDA(At, 0, 1); PG8_STAGE(PG8_SB(0, 0), b2, voffB); PG8_STAGE(PG8_SB(0, 1), b2 + hstepB, voffB); PG8_STAGE(PG8_SA(0, 0), a2, voffA);
            PG8_WAIT_V(8); PG8_WAIT_L(0); PG8_BAR; PG8_MMA(1, 0, At, B0); PG8_MMA(1, 1, At, B1); PG8_BAR; PG8_SCHED;
            PG8_LDB(B0, 1, 0); PG8_LDB(B1, 1, 1); PG8_SCHED; PG8_LDA(At, 1, 0); PG8_STAGE(PG8_SA(0, 1), a2 + hstepA, voffA);
            PG8_WAIT_V(8); PG8_WAIT_L(0); PG8_BAR; PG8_MMA(0, 0, At, B0); PG8_MMA(0, 1, At, B1); PG8_BAR; PG8_SCHED;
            PG8_LDA(At, 1, 1); PG8_STAGE(PG8_SB(1, 0), b3, voffB); PG8_STAGE(PG8_SB(1, 1), b3 + hstepB, voffB); PG8_STAGE(PG8_SA(1, 0), a3, voffA);
            PG8_WAIT_V(8); PG8_WAIT_L(0); PG8_BAR; PG8_MMA(1, 0, At, B0); PG8_MMA(1, 1, At, B1); PG8_BAR; PG8_SCHED;
        }
        if (wr == 0) PG8_BAR;
        { const int l2 = fresh_lane(); E(acc, cur, wr, wc, l2 & 15, l2 >> 4); }
        if (!has_next) break;
#pragma unroll
        for (int a = 0; a < 2; ++a)
#pragma unroll
            for (int b = 0; b < 2; ++b)
#pragma unroll
                for (int m = 0; m < 4; ++m)
#pragma unroll
                    for (int n = 0; n < 2; ++n) acc[a][b][m][n] = (f32x4){0.f, 0.f, 0.f, 0.f};
        cur = nxt; cA = nA; cB = nB; ++ui;
        if (wr == 1) PG8_BAR;
    }
    PG8_WAIT_V(0);
    PG8_BAR;
#undef PG8_ABASE
#undef PG8_BBASE
#undef PG8_SA
#undef PG8_SB
#undef PG8_STAGE
#undef PG8_LDA
#undef PG8_LDB
#undef PG8_MMA
#undef PG8_WAIT_V
#undef PG8_WAIT_L
#undef PG8_BAR
#undef PG8_SCHED
}
}
using pg8::Unit;

struct EpiZ {
    static constexpr bool PERM = true;
    bf16_t* Z; const float* c64; const float* s64; const float* c32; const float* s32; float* ssq;
    __device__ __forceinline__ void operator()(const f32x4 (&acc)[2][2][4][2], const Unit& u, int wr, int wc, int fr, int fq) const {
        const int row0 = u.pm * 256 + wr * 64 + fr; const bool latent = u.pm < (NLAT / 256);
        if (u.pn == Z_CQ / 256 || u.pn == Z_CKV / 256) {
            const bool isq = (u.pn == Z_CQ / 256);
#pragma unroll
            for (int ai = 0; ai < 2; ++ai)
#pragma unroll
                for (int m = 0; m < 4; ++m) {
                    float ss = 0.f;
#pragma unroll
                    for (int bj = 0; bj < 2; ++bj) if (isq || bj == 0) {
                        const f32x4 a0 = acc[ai][bj][m][0], a1 = acc[ai][bj][m][1];
                        ss += (a0[0] * a0[0] + a0[1] * a0[1]) + (a0[2] * a0[2] + a0[3] * a0[3]) + (a1[0] * a1[0] + a1[1] * a1[1]) + (a1[2] * a1[2] + a1[3] * a1[3]);
                    }
                    ss += swz_xor<16>(ss); ss = xhalf_sum(ss);
                    if (fq == 0) __hip_atomic_fetch_add(ssq + (isq ? 0 : MROWS) + row0 + ai * 128 + m * 16, ss, __ATOMIC_RELAXED, __HIP_MEMORY_SCOPE_AGENT);
                }
        }
#pragma unroll
        for (int bj = 0; bj < 2; ++bj) {
            const int col0 = u.pn * 256 + bj * 128 + wc * 32 + 8 * fq;
            int mode = 0, i0 = 0;
            if (latent) {
                if (col0 >= Z_SWQ && col0 < Z_SWV) { mode = 1; i0 = (((col0 - Z_SWQ) & 63) >> 3) << 2; }
                else if ((col0 >= Z_DFQ && col0 < Z_DFV) || (col0 >= Z_KR && col0 < Z_KR + 32)) { mode = 2; i0 = ((col0 & 31) >> 3) << 2; }
            }
            const bool dfq = col0 >= Z_DFQ && col0 < Z_DFK;
            const float* ct = mode == 1 ? c64 + i0 : c32 + i0; const float* st = mode == 1 ? s64 + i0 : s32 + i0; const int tw = mode == 1 ? 32 : 16;
#pragma unroll
            for (int ai = 0; ai < 2; ++ai) {
                f32x4 cc[4], sn[4];
                if (mode) {
#pragma unroll
                    for (int m = 0; m < 4; ++m) { const int pos = (row0 + ai * 128 + m * 16) & (SEQ - 1); cc[m] = gld<f32x4>(ct + pos * tw); sn[m] = gld<f32x4>(st + pos * tw); }
                }
#pragma unroll
                for (int m = 0; m < 4; ++m) {
                    const int row = row0 + ai * 128 + m * 16;
                    f32x4 v0 = acc[ai][bj][m][0], v1 = acc[ai][bj][m][1];
                    if (dfq) { v0 = v0 * (0.17677669529663687f * LOG2E); v1 = v1 * (0.17677669529663687f * LOG2E); }
                    if (mode) { const f32x4 o0 = v0 * cc[m] - v1 * sn[m], o1 = v0 * sn[m] + v1 * cc[m]; v0 = o0; v1 = o1; }
                    u32x4 w; w.x = cvt_pk_bf16(v0[0], v0[1]); w.y = cvt_pk_bf16(v0[2], v0[3]); w.z = cvt_pk_bf16(v1[0], v1[1]); w.w = cvt_pk_bf16(v1[2], v1[3]);
                    gst<u32x4>(Z + (size_t)row * NZ + col0, w);
                }
                asm volatile("" ::: "memory");
            }
        }
    }
};
struct EpiQ {
    static constexpr bool PERM = true;
    const float* ssq; bf16_t* Qm; const float* c32; const float* s32;
    __device__ __forceinline__ void operator()(const f32x4 (&acc)[2][2][4][2], const Unit& u, int wr, int wc, int fr, int fq) const {
        const int row0 = u.pm * 256 + wr * 64 + fr; const bool latent = u.pm < (NLAT / 256);
#pragma unroll
        for (int ai = 0; ai < 2; ++ai) {
            float rstd[4];
#pragma unroll
            for (int m = 0; m < 4; ++m) rstd[m] = gld<float>(ssq + row0 + ai * 128 + m * 16);
#pragma unroll
            for (int m = 0; m < 4; ++m) rstd[m] = (0.10206207261596575f * LOG2E) / sqrtf(rstd[m] * (1.0f / 192.0f) + EPS);
#pragma unroll
            for (int bj = 0; bj < 2; ++bj) {
                const int col0 = u.pn * 256 + bj * 128 + wc * 32 + 8 * fq;
                if (col0 < 384) {
                    const int p = col0 % 96; const bool rope = latent && p >= 64; const int i0 = ((p - 64) >> 3) << 2;
                    f32x4 cc[4], sn[4];
                    if (rope) {
#pragma unroll
                        for (int m = 0; m < 4; ++m) { const int pos = (row0 + ai * 128 + m * 16) & (SEQ - 1); cc[m] = gld<f32x4>(c32 + pos * 16 + i0); sn[m] = gld<f32x4>(s32 + pos * 16 + i0); }
                    }
#pragma unroll
                    for (int m = 0; m < 4; ++m) {
                        const int row = row0 + ai * 128 + m * 16;
                        f32x4 v0 = acc[ai][bj][m][0] * rstd[m], v1 = acc[ai][bj][m][1] * rstd[m];
                        if (rope) { const f32x4 o0 = v0 * cc[m] - v1 * sn[m], o1 = v0 * sn[m] + v1 * cc[m]; v0 = o0; v1 = o1; }
                        u32x4 w; w.x = cvt_pk_bf16(v0[0], v0[1]); w.y = cvt_pk_bf16(v0[2], v0[3]); w.z = cvt_pk_bf16(v1[0], v1[1]); w.w = cvt_pk_bf16(v1[2], v1[3]);
                        gst<u32x4>(Qm + (size_t)row * 384 + col0, w);
                    }
                }
                asm volatile("" ::: "memory");
            }
        }
    }
};
struct EpiKV {
    static constexpr bool PERM = true;
    const float* ssq; bf16_t* Km; bf16_t* Vm;
    __device__ __forceinline__ void operator()(const f32x4 (&acc)[2][2][4][2], const Unit& u, int wr, int wc, int fr, int fq) const {
        const int row0 = u.pm * 256 + wr * 64 + fr;
        bf16_t* dst = u.pn == 0 ? Km : Vm;
#pragma unroll
        for (int ai = 0; ai < 2; ++ai) {
            float rstd[4];
#pragma unroll
            for (int m = 0; m < 4; ++m) rstd[m] = gld<float>(ssq + MROWS + row0 + ai * 128 + m * 16);
#pragma unroll
            for (int m = 0; m < 4; ++m) rstd[m] = 1.0f / sqrtf(rstd[m] * (1.0f / 128.0f) + EPS);
#pragma unroll
            for (int m = 0; m < 4; ++m) {
                const int row = row0 + ai * 128 + m * 16;
#pragma unroll
                for (int bj = 0; bj < 2; ++bj) {
                    const int col0 = bj * 128 + wc * 32 + 8 * fq;
                    const f32x4 v0 = acc[ai][bj][m][0] * rstd[m], v1 = acc[ai][bj][m][1] * rstd[m];
                    u32x4 w; w.x = cvt_pk_bf16(v0[0], v0[1]); w.y = cvt_pk_bf16(v0[2], v0[3]); w.z = cvt_pk_bf16(v1[0], v1[1]); w.w = cvt_pk_bf16(v1[2], v1[3]);
                    gst<u32x4>(dst + (size_t)row * 256 + col0, w);
                }
            }
            asm volatile("" ::: "memory");
        }
    }
};
struct EpiRes {
    static constexpr bool PERM = false;
    const float* xl_in; const float* xc_in; float* xl_out; float* xc_out; const float* modl; int goff;
    __device__ __forceinline__ void operator()(const f32x4 (&acc)[2][2][4][2], const Unit& u, int wr, int wc, int fr, int fq) const {
        const bool latent = u.pm < (NLAT / 256);
        const float* xin = latent ? xl_in + (size_t)u.pm * 256 * DM : xc_in + (size_t)(u.pm - NLAT / 256) * 256 * DM;
        float* xout = latent ? xl_out + (size_t)u.pm * 256 * DM : xc_out + (size_t)(u.pm - NLAT / 256) * 256 * DM;
        const float* gate = modl + (size_t)(latent ? (u.pm >> 3) : 16) * 6144 + goff;
        const int r0 = wr * 64 + fr, c0 = u.pn * 256 + wc * 32 + 4 * fq;
#pragma unroll
        for (int bj = 0; bj < 2; ++bj)
#pragma unroll
            for (int n = 0; n < 2; ++n) {
                const int col = c0 + bj * 128 + n * 16;
                const f32x4 gv = gld<f32x4>(gate + col);
                f32x4 xi[2][4];
#pragma unroll
                for (int ai = 0; ai < 2; ++ai)
#pragma unroll
                    for (int m = 0; m < 4; ++m) xi[ai][m] = gld<f32x4>(xin + (size_t)(r0 + ai * 128 + m * 16) * DM + col);
#pragma unroll
                for (int ai = 0; ai < 2; ++ai)
#pragma unroll
                    for (int m = 0; m < 4; ++m) gst<f32x4>(xout + (size_t)(r0 + ai * 128 + m * 16) * DM + col, xi[ai][m] + gv * acc[ai][bj][m][n]);
                asm volatile("" ::: "memory");
            }
    }
};
struct EpiCtxSplit {
    static constexpr bool PERM = false;
    float* xc; bf16_t* part; const float* modl; int goff;
    __device__ __forceinline__ void operator()(const f32x4 (&acc)[2][2][4][2], const Unit& u, int wr, int wc, int fr, int fq) const {
        const int kc = u.pm >> 4, rt = u.pm & 15;
        const int r0 = rt * 256 + wr * 64 + fr, c0 = u.pn * 256 + wc * 32 + 4 * fq;
        if (kc == 0) {
            const float* gate = modl + (size_t)16 * 6144 + goff;
#pragma unroll
            for (int bj = 0; bj < 2; ++bj)
#pragma unroll
                for (int n = 0; n < 2; ++n) {
                    const int col = c0 + bj * 128 + n * 16;
                    const f32x4 gv = gld<f32x4>(gate + col);
                    f32x4 xi[2][4];
#pragma unroll
                    for (int ai = 0; ai < 2; ++ai)
#pragma unroll
                        for (int m = 0; m < 4; ++m) xi[ai][m] = gld<f32x4>(xc + (size_t)(r0 + ai * 128 + m * 16) * DM + col);
#pragma unroll
                    for (int ai = 0; ai < 2; ++ai)
#pragma unroll
                        for (int m = 0; m < 4; ++m) gst<f32x4>(xc + (size_t)(r0 + ai * 128 + m * 16) * DM + col, xi[ai][m] + gv * acc[ai][bj][m][n]);
                    asm volatile("" ::: "memory");
                }
        } else {
            bf16_t* P = part + (size_t)(kc - 1) * NCTX * DM;
#pragma unroll
            for (int bj = 0; bj < 2; ++bj)
#pragma unroll
                for (int n = 0; n < 2; ++n) {
                    const int col = c0 + bj * 128 + n * 16;
#pragma unroll
                    for (int ai = 0; ai < 2; ++ai)
#pragma unroll
                        for (int m = 0; m < 4; ++m) { const f32x4 v = acc[ai][bj][m][n]; u32x2 w; w.x = cvt_pk_bf16(v[0], v[1]); w.y = cvt_pk_bf16(v[2], v[3]);
                            gst<u32x2>(P + (size_t)(r0 + ai * 128 + m * 16) * DM + col, w); }
                }
        }
    }
};
struct EpiUp {
    static constexpr bool PERM = true;
    bf16_t* U;
    __device__ __forceinline__ void operator()(const f32x4 (&acc)[2][2][4][2], const Unit& u, int wr, int wc, int fr, int fq) const {
        const int row0 = u.pm * 256 + wr * 64 + fr;
#pragma unroll
        for (int bj = 0; bj < 2; ++bj) {
            const int col0 = u.pn * 256 + bj * 128 + wc * 32 + 8 * fq;
#pragma unroll
            for (int ai = 0; ai < 2; ++ai)
#pragma unroll
                for (int m = 0; m < 4; ++m) {
                    const int row = row0 + ai * 128 + m * 16;
                    f32x4 v0 = acc[ai][bj][m][0], v1 = acc[ai][bj][m][1];
#pragma unroll
                    for (int j = 0; j < 4; ++j) { const float a = fmaxf(v0[j], 0.f), b = fmaxf(v1[j], 0.f); v0[j] = a * a; v1[j] = b * b; }
                    u32x4 w; w.x = cvt_pk_bf16(v0[0], v0[1]); w.y = cvt_pk_bf16(v0[2], v0[3]); w.z = cvt_pk_bf16(v1[0], v1[1]); w.w = cvt_pk_bf16(v1[2], v1[3]);
                    gst_nt<u32x4>(U + (size_t)row * DFF + col0, w);
                    asm volatile("" ::: "memory");
                }
        }
    }
};

struct Args { const float* in[21]; float* out; unsigned char* ws; };
enum { I_X = 0, I_C, I_CTX, I_CCTX, I_WADA, I_BADA, I_GATTN, I_WIN, I_RPB, I_GQ, I_WUQ, I_GKV, I_WUKV, I_SINK, I_LAMBDA, I_GDIFF, I_WOUT, I_GMLP, I_WUP, I_WDOWN, I_GFINAL };

__device__ __forceinline__ float wave_sum(float v) {
    v += swz_xor<1>(v); v += swz_xor<2>(v); v += swz_xor<4>(v); v += swz_xor<8>(v); v += swz_xor<16>(v);
    return xhalf_sum(v);
}

__device__ __forceinline__ int unperm64(int pp) { const int g = pp >> 3, e = pp & 7; return e < 4 ? 4 * g + e : 32 + 4 * g + (e - 4); }
__device__ __forceinline__ int unperm32(int pp) { const int g = pp >> 3, e = pp & 7; return e < 4 ? 4 * g + e : 16 + 4 * g + (e - 4); }
__device__ __forceinline__ int zmap(int n) {
    if (n < 768) return n;
    if (n < 1024) { const int p = n - 768; return 1120 + (p & ~63) + unperm64(p & 63); }
    if (n < 1152) { const int p = n - 1024; return 1376 + (p & ~63) + unperm64(p & 63); }
    if (n < 1280) return 1504 + (n - 1152);
    if (n < 1536) { const int p = n - 1280; return 1632 + (p & ~31) + unperm32(p & 31); }
    if (n < 1792) { const int p = n - 1536; return 1888 + (p & ~31) + unperm32(p & 31); }
    if (n < 2048) return 2144 + (n - 1792);
    if (n < 2304) { const int p = n - 2048; return p < 192 ? 768 + p : -1; }
    if (n < 2432) return 960 + (n - 2304);
    if (n < 2464) return 1088 + unperm32(n - 2432);
    return -1;
}
__device__ __forceinline__ int uqmap(int n) { if (n >= 384) return -1; const int hd = n / 96, p = n % 96; return hd * 96 + (p < 64 ? p : 64 + unperm32(p - 64)); }
__device__ __forceinline__ int ukvmap(int n) { if (n < 256) return (n >> 6) * 128 + (n & 63); const int q = n - 256; return (q >> 6) * 128 + 64 + (q & 63); }
template <int MODE>
__device__ __forceinline__ void transpose_item(const float* W, int ldw, int Kvalid, int Kpad, int Npad, bf16_t* WT, const float* kscale, LAS float* scr, int item, int lane) {
    const int nblk = Npad / 32, kb = item / nblk, nb = item % nblk, k0 = 64 * kb, n0 = 32 * nb;
    const int n = n0 + (lane & 31);
    const int sc = MODE == 0 ? n : MODE == 1 ? zmap(n) : MODE == 2 ? uqmap(n) : ukvmap(n);
#pragma unroll
    for (int i = 0; i < 32; ++i) { const int kk = 2 * i + (lane >> 5), k = k0 + kk; float v = 0.f;
        if (sc >= 0 && k < Kvalid) { v = W[(size_t)k * ldw + sc]; if (kscale) v *= kscale[k]; }
        scr[kk * 33 + (lane & 31)] = v; }
    asm volatile("s_waitcnt lgkmcnt(0)" ::: "memory");
    const int c = lane & 7;
#pragma unroll
    for (int j = 0; j < 4; ++j) { const int nn = (lane >> 3) + 8 * j; const LAS float* s = scr + (8 * c) * 33 + nn;
        u32x4 o; o.x = cvt_pk_bf16(s[0 * 33], s[1 * 33]); o.y = cvt_pk_bf16(s[2 * 33], s[3 * 33]); o.z = cvt_pk_bf16(s[4 * 33], s[5 * 33]); o.w = cvt_pk_bf16(s[6 * 33], s[7 * 33]);
        gst<u32x4>(WT + (size_t)(n0 + nn) * Kpad + k0 + 8 * c, o); }
    asm volatile("s_waitcnt lgkmcnt(0)" ::: "memory");
}

__device__ __forceinline__ void phase0(const Args& a, LAS unsigned char* lds, const int wv) {
    const int tid = fresh_tid(wv), lane = tid & 63, wid = wv, G = gridDim.x;
    unsigned char* ws = a.ws;
    {
        LAS float* scr = (LAS float*)(lds + wid * 16384);
        const int gw = blockIdx.x * 8 + wid, NGW = G * 8;
        constexpr int I_IN = 16 * (NZ / 32), I_OUT = 16 * 32, I_UP = 16 * 128, I_DN = 64 * 32, I_UQ = 4 * 16, I_UKV = 2 * 16;
        constexpr int PER_L = I_IN + I_OUT + I_UP + I_DN + I_UQ + I_UKV;
        for (int it = gw; it < DEPTH * PER_L; it += NGW) {
            const int l = it / PER_L; int r = it % PER_L;
            if (r < I_IN) { transpose_item<1>(a.in[I_WIN] + (size_t)l * DM * INC, INC, DM, DM, NZ, (bf16_t*)(ws + WS_WIN) + (size_t)l * NZ * DM, nullptr, scr, r, lane); continue; } r -= I_IN;
            if (r < I_OUT) { transpose_item<0>(a.in[I_WOUT] + (size_t)l * DM * DM, DM, DM, DM, DM, (bf16_t*)(ws + WS_WOUT) + (size_t)l * DM * DM, nullptr, scr, r, lane); continue; } r -= I_OUT;
            if (r < I_UP) { transpose_item<0>(a.in[I_WUP] + (size_t)l * DM * DFF, DFF, DM, DM, DFF, (bf16_t*)(ws + WS_WUP) + (size_t)l * DFF * DM, nullptr, scr, r, lane); continue; } r -= I_UP;
            if (r < I_DN) { transpose_item<0>(a.in[I_WDOWN] + (size_t)l * DFF * DM, DM, DFF, DFF, DM, (bf16_t*)(ws + WS_WDOWN) + (size_t)l * DM * DFF, nullptr, scr, r, lane); continue; } r -= I_DN;
            if (r < I_UQ) { transpose_item<2>(a.in[I_WUQ] + (size_t)l * 192 * 384, 384, 192, 256, 512, (bf16_t*)(ws + WS_WUQ) + (size_t)l * 512 * 256, a.in[I_GQ] + l * 192, scr, r, lane); continue; } r -= I_UQ;
            transpose_item<3>(a.in[I_WUKV] + (size_t)l * 128 * 512, 512, 128, 128, 512, (bf16_t*)(ws + WS_WUKV) + (size_t)l * 512 * 128, a.in[I_GKV] + l * 128, scr, r, lane);
        }
    }
    {
        float* c64 = (float*)(ws + WS_ROPE); float* s64 = c64 + SEQ * 32; float* c32 = s64 + SEQ * 32; float* s32 = c32 + SEQ * 16;
        const int gt = blockIdx.x * 512 + tid, NT = G * 512;
        for (int idx = gt; idx < SEQ * 32; idx += NT) { const int pos = idx >> 5, i = idx & 31; const int rr = pos >> 6, cc = pos & 63;
            const float f = powf(10000.0f, -(float)(i & 15) / 16.0f); const float ang = (float)(i < 16 ? rr : cc) * f; c64[idx] = cosf(ang); s64[idx] = sinf(ang); }
        for (int idx = gt; idx < SEQ * 16; idx += NT) { const int pos = idx >> 4, i = idx & 15; const int rr = pos >> 6, cc = pos & 63;
            const float f = powf(10000.0f, -(float)(i & 7) / 8.0f); const float ang = (float)(i < 8 ? rr : cc) * f; c32[idx] = cosf(ang); s32[idx] = sinf(ang); }
        if (blockIdx.x == 0 && tid < DEPTH) { const float* lp = a.in[I_LAMBDA] + tid * 128; float s1 = 0.f, s2 = 0.f;
            for (int i = 0; i < 32; ++i) { s1 += lp[i] * lp[32 + i]; s2 += lp[64 + i] * lp[96 + i]; }
            const float lam_init = 0.8f - 0.6f * expf(-0.3f * (float)tid);
            float* lamp = (float*)(ws + WS_LAM); lamp[2 * tid] = expf(s1) - expf(s2) + lam_init; lamp[2 * tid + 1] = lam_init; }
    }
    __syncthreads();
    if ((int)blockIdx.x < DEPTH * 96) {
        LAS float* act = (LAS float*)lds; LAS float* red = act + 17 * 1024;
        for (int idx = tid; idx < 17 * 1024; idx += 512) { const int i = idx >> 10, k = idx & 1023; const float v = i < 16 ? a.in[I_C][i * 1024 + k] : a.in[I_CCTX][k]; act[idx] = v / (1.0f + expf(-v)); }
        __syncthreads();
        float* mod = (float*)(ws + WS_MOD);
        for (int it = blockIdx.x; it < DEPTH * 96; it += G) {
            const int l = it / 96, j0 = (it % 96) * 64, col = tid & 63, ks = tid >> 6;
            float acc[17];
#pragma unroll
            for (int i = 0; i < 17; ++i) acc[i] = 0.f;
            const float* w = a.in[I_WADA] + ((size_t)l * 1024 + ks * 128) * 6144 + j0 + col;
            const LAS float* ak = act + ks * 128;
#pragma unroll 4
            for (int k = 0; k < 128; ++k) { const float wv = w[(size_t)k * 6144];
#pragma unroll
                for (int i = 0; i < 17; ++i) acc[i] += ak[i * 1024 + k] * wv; }
#pragma unroll
            for (int i = 0; i < 17; ++i) red[(ks * 17 + i) * 64 + col] = acc[i];
            __syncthreads();
            for (int idx = tid; idx < 17 * 64; idx += 512) { const int i = idx >> 6, cc = idx & 63; float s = 0.f;
#pragma unroll
                for (int q = 0; q < 8; ++q) s += red[(q * 17 + i) * 64 + cc];
                mod[(size_t)(l * 17 + i) * 6144 + j0 + cc] = s + a.in[I_BADA][l * 6144 + j0 + cc]; }
            __syncthreads();
        }
    }
}

__device__ __forceinline__ void norm_phase(const float* xl, const float* xc, const float* g, const float* modl, int shoff, int scoff, bf16_t* H, int nrows, const int wv, float* ssq,
                                           const bf16_t* part, const float* gate_prev, float* xc_w) {
    const int tidn = fresh_tid(wv); const int lane = tidn & 63, gw = blockIdx.x * 8 + (tidn >> 6), NGW = gridDim.x * 8;
    for (int row0 = gw; row0 < nrows; row0 += 2 * NGW) {
        f32x4 v[2][4]; float s[2] = {0.f, 0.f}; bool ok[2];
#pragma unroll
        for (int q = 0; q < 2; ++q) {
            const int row = row0 + q * NGW; ok[q] = row < nrows;
            if (ok[q]) {
                const float* src = row < NLAT ? xl + (size_t)row * DM : xc + (size_t)(row - NLAT) * DM;
#pragma unroll
                for (int j = 0; j < 4; ++j) v[q][j] = gld_nt<f32x4>(src + 4 * lane + 256 * j);
                if (ssq && lane < 2) ssq[lane * MROWS + row] = 0.f;
                if (part && row >= NLAT) {
                    const size_t ro = (size_t)(row - NLAT) * DM;
#pragma unroll
                    for (int j = 0; j < 4; ++j) { const int col = 4 * lane + 256 * j; f32x4 pa = {0.f, 0.f, 0.f, 0.f};
#pragma unroll
                        for (int c = 0; c < 3; ++c) { const u32x2 w = gld<u32x2>(part + (size_t)c * NCTX * DM + ro + col); pa[0] += bf_lo(w.x); pa[1] += bf_hi(w.x); pa[2] += bf_lo(w.y); pa[3] += bf_hi(w.y); }
                        v[q][j] += gld<f32x4>(gate_prev + col) * pa;
                        gst<f32x4>(xc_w + ro + col, v[q][j]); }
                }
            }
        }
#pragma unroll
        for (int q = 0; q < 2; ++q) if (ok[q]) {
            const int row = row0 + q * NGW;
#pragma unroll
            for (int j = 0; j < 4; ++j) s[q] += (v[q][j][0] * v[q][j][0] + v[q][j][1] * v[q][j][1]) + (v[q][j][2] * v[q][j][2] + v[q][j][3] * v[q][j][3]);
            const float rstd = 1.0f / sqrtf(wave_sum(s[q]) * (1.0f / DM) + EPS);
            const float* mr = modl + (size_t)(row < NLAT ? (row >> 11) : 16) * 6144;
#pragma unroll
            for (int j = 0; j < 4; ++j) { const int col = 4 * lane + 256 * j;
                const f32x4 gg = gld<f32x4>(g + col), sc = gld<f32x4>(mr + scoff + col), sh = gld<f32x4>(mr + shoff + col);
                const f32x4 y = (v[q][j] * rstd * gg) * (sc + 1.0f) + sh;
                u32x2 w; w.x = cvt_pk_bf16(y[0], y[1]); w.y = cvt_pk_bf16(y[2], y[3]);
                gst<u32x2>(H + (size_t)row * DM + col, w); }
        }
    }
}
__device__ __forceinline__ void final_norm_phase(float* x, const float* g, const int wv) {
    const int tidn = fresh_tid(wv); const int lane = tidn & 63, gw = blockIdx.x * 8 + (tidn >> 6), NGW = gridDim.x * 8;
    for (int row0 = gw; row0 < NLAT; row0 += 2 * NGW) {
        f32x4 v[2][4]; bool ok[2];
#pragma unroll
        for (int q = 0; q < 2; ++q) { const int row = row0 + q * NGW; ok[q] = row < NLAT;
            if (ok[q]) {
#pragma unroll
                for (int j = 0; j < 4; ++j) v[q][j] = gld<f32x4>(x + (size_t)row * DM + 4 * lane + 256 * j); } }
#pragma unroll
        for (int q = 0; q < 2; ++q) if (ok[q]) {
            float* src = x + (size_t)(row0 + q * NGW) * DM; float s = 0.f;
#pragma unroll
            for (int j = 0; j < 4; ++j) s += (v[q][j][0] * v[q][j][0] + v[q][j][1] * v[q][j][1]) + (v[q][j][2] * v[q][j][2] + v[q][j][3] * v[q][j][3]);
            const float rstd = 1.0f / sqrtf(wave_sum(s) * (1.0f / DM) + EPS);
#pragma unroll
            for (int j = 0; j < 4; ++j) { const int col = 4 * lane + 256 * j; const f32x4 gg = gld<f32x4>(g + col); gst<f32x4>(src + col, v[q][j] * rstd * gg); }
        }
    }
}

constexpr int KSTR = 208, VSTR = 192;
constexpr int AL_K = 0, AL_V = 2 * 64 * KSTR, AL_RPB = AL_V + 2 * 64 * VSTR;
__device__ __forceinline__ int crow(int r, int hi) { return (r & 3) + 8 * (r >> 2) + 4 * hi; }

constexpr float RESCALE_THR = 8.0f;
struct TileRegs { u32x4 k, k2, v; };
typedef short v4i16_t __attribute__((ext_vector_type(4)));
__device__ __forceinline__ s16x4 vtr16(const LAS unsigned char* p) { return __builtin_bit_cast(s16x4, __builtin_amdgcn_ds_read_tr16_b64_v4i16((LAS v4i16_t*)p)); }
typedef float f32x2 __attribute__((ext_vector_type(2)));


template <int MT, int NSTEP, int NI>
__device__ __forceinline__ void attn_compute(LAS unsigned char* lds, int buf, const bf16x8 (&qf)[NSTEP], float (&mrun)[NI], float (&lrun)[NI], f32x16 (&o)[NI][2], f32x16 (&negm)[NI], bool first,
                                             bool masked, int T, int r32, int hi, float sc2, int rq, int cq, int c0, int qpos) {
    const LAS unsigned char* kb = lds + AL_K + buf * 64 * KSTR; const LAS unsigned char* vb = lds + AL_V + buf * 64 * VSTR;
    const LAS float* rpbL = (const LAS float*)(lds + AL_RPB);
    bf16x8 vfr[2][4];
#pragma unroll
    for (int t = 0; t < NI; ++t) {
        constexpr int SB = (MT == 3) ? 2 : NSTEP;
        bf16x8 kf0[SB], kf1[SB];
#pragma unroll
        for (int st = 0; st < SB; ++st) {
            const int sg = (MT == 3) ? 2 * t + st : st;
            kf0[st] = *(const LAS bf16x8*)(kb + r32 * KSTR + sg * 32 + hi * 16);
            kf1[st] = *(const LAS bf16x8*)(kb + (32 + r32) * KSTR + sg * 32 + hi * 16);
        }
        if (t == 0) {
            const LAS unsigned char* vl = vb + (4 * hi + ((r32 & 15) >> 2)) * VSTR + (16 * ((r32 >> 4) & 1) + 4 * (r32 & 3)) * 2;
#pragma unroll
            for (int db = 0; db < 2; ++db) {
#pragma unroll
                for (int ks = 0; ks < 4; ++ks) {
                    const s16x4 lo = vtr16(vl + (16 * ks) * VSTR + 64 * db);
                    const s16x4 hh = vtr16(vl + (16 * ks + 8) * VSTR + 64 * db);
                    vfr[db][ks] = (bf16x8){lo[0], lo[1], lo[2], lo[3], hh[0], hh[1], hh[2], hh[3]};
                }
            }
        }
        __builtin_amdgcn_sched_barrier(0);
        constexpr bool CINIT = (MT == 1 || MT == 3);
        f32x16 s0 = f32x16{}, s1 = f32x16{};
#pragma unroll
        for (int st = 0; st < SB; ++st) {
            const int sg = (MT == 3) ? 2 * t + st : st;
            if (CINIT && st == 0) { s0 = __builtin_amdgcn_mfma_f32_32x32x16_bf16(kf0[st], qf[sg], negm[t], 0, 0, 0); s1 = __builtin_amdgcn_mfma_f32_32x32x16_bf16(kf1[st], qf[sg], negm[t], 0, 0, 0); }
            else { s0 = __builtin_amdgcn_mfma_f32_32x32x16_bf16(kf0[st], qf[sg], s0, 0, 0, 0); s1 = __builtin_amdgcn_mfma_f32_32x32x16_bf16(kf1[st], qf[sg], s1, 0, 0, 0); }
        }
        asm volatile("s_nop 15\n\ts_nop 7" : "+v"(s0), "+v"(s1));
        float mnew;
        if (CINIT) {
            float ma = max3f(s0[0], s0[1], s1[0]), mb = max3f(s0[2], s0[3], s1[1]); ma = max3f(ma, s1[2], s1[3]);
#pragma unroll
            for (int r = 4; r < 16; r += 4) { ma = max3f(ma, s0[r], s0[r + 1]); mb = max3f(mb, s0[r + 2], s0[r + 3]); ma = max3f(ma, s1[r], s1[r + 1]); mb = max3f(mb, s1[r + 2], s1[r + 3]); }
            const float mx = xhalf_max(max2f(ma, mb));
            if (first || __any(mx > RESCALE_THR)) {
                const float delta = first ? mx : fmaxf(mx, 0.f);
#pragma unroll
                for (int r = 0; r < 16; ++r) { s0[r] -= delta; s1[r] -= delta; }
                if (!first) { const float alpha = __builtin_amdgcn_exp2f(-delta); lrun[t] *= alpha;
#pragma unroll
                    for (int r = 0; r < 16; ++r) { o[t][0][r] *= alpha; o[t][1][r] *= alpha; } }
                mrun[t] += delta;
                const float nmv = -mrun[t];
#pragma unroll
                for (int r = 0; r < 16; ++r) negm[t][r] = nmv;
            }
#pragma unroll
            for (int r = 0; r < 16; ++r) { s0[r] = __builtin_amdgcn_exp2f(s0[r]); s1[r] = __builtin_amdgcn_exp2f(s1[r]); }
            mnew = mrun[t];
        } else if ((MT == 0 || MT == 2) && masked) {
            float mx = NEGBIG;
#pragma unroll
            for (int r = 0; r < 16; ++r) {
                const int k0 = crow(r, hi), k1 = 32 + k0;
                float v0 = s0[r] * sc2, v1 = s1[r] * sc2;
                if (MT == 0) {
                    const int bi = (T - rq + 7) * 31 + 15 - cq;
                    const bool ok0 = (k0 >= c0) && (k0 < c0 + 16), ok1 = (k1 >= c0) && (k1 < c0 + 16);
                    const float b0 = ok0 ? rpbL[bi + k0] : 0.f, b1 = ok1 ? rpbL[bi + k1] : 0.f;
                    v0 = ok0 ? v0 + b0 : NEGBIG; v1 = ok1 ? v1 + b1 : NEGBIG;
                } else {
                    const int d0 = 64 * T + k0 - qpos, d1 = d0 + 32;
                    v0 = (d0 >= -128 && d0 <= 128) ? v0 : NEGBIG; v1 = (d1 >= -128 && d1 <= 128) ? v1 : NEGBIG;
                }
                s0[r] = v0; s1[r] = v1; mx = fmaxf(mx, fmaxf(v0, v1));
            }
            mx = xhalf_max(mx);
            mnew = mrun[t];
            if (__any(mx > mrun[t] + RESCALE_THR)) mnew = fmaxf(mrun[t], mx);
#pragma unroll
            for (int r = 0; r < 16; ++r) { s0[r] = __builtin_amdgcn_exp2f(s0[r] - mnew); s1[r] = __builtin_amdgcn_exp2f(s1[r] - mnew); }
        } else {
            float ma = max3f(s0[0], s0[1], s1[0]), mb = max3f(s0[2], s0[3], s1[1]); ma = max3f(ma, s1[2], s1[3]);
#pragma unroll
            for (int r = 4; r < 16; r += 4) { ma = max3f(ma, s0[r], s0[r + 1]); mb = max3f(mb, s0[r + 2], s0[r + 3]); ma = max3f(ma, s1[r], s1[r + 1]); mb = max3f(mb, s1[r + 2], s1[r + 3]); }
            const float mx = xhalf_max(max2f(ma, mb));
            mnew = mrun[t];
            if (__any(mx * sc2 > mrun[t] + RESCALE_THR)) mnew = fmaxf(mrun[t], mx * sc2);
            const f32x2 nm2 = {-mnew, -mnew}, sc22 = {sc2, sc2};
#pragma unroll
            for (int r = 0; r < 16; r += 2) {
                const f32x2 e0 = (f32x2){s0[r], s0[r + 1]} * sc22 + nm2, e1 = (f32x2){s1[r], s1[r + 1]} * sc22 + nm2;
                s0[r] = __builtin_amdgcn_exp2f(e0.x); s0[r + 1] = __builtin_amdgcn_exp2f(e0.y); s1[r] = __builtin_amdgcn_exp2f(e1.x); s1[r + 1] = __builtin_amdgcn_exp2f(e1.y);
            }
        }
        f32x2 ls2 = {0.f, 0.f};
#pragma unroll
        for (int r = 0; r < 16; r += 2) { ls2 += (f32x2){s0[r], s0[r + 1]}; ls2 += (f32x2){s1[r], s1[r + 1]}; }
        const float ls = ls2.x + ls2.y;
        if (!CINIT && __any(mnew > mrun[t])) {
            const float alpha = __builtin_amdgcn_exp2f(mrun[t] - mnew);
            lrun[t] *= alpha;
#pragma unroll
            for (int r = 0; r < 16; ++r) { o[t][0][r] *= alpha; o[t][1][r] *= alpha; }
        }
        mrun[t] = mnew; lrun[t] += ls;
        bf16x8 pf[4];
#pragma unroll
        for (int ks = 0; ks < 4; ++ks) { u32x4 w;
            if (ks < 2) { const int bse = 8 * ks; w.x = cvt_pk_bf16(s0[bse], s0[bse + 1]); w.y = cvt_pk_bf16(s0[bse + 2], s0[bse + 3]); w.z = cvt_pk_bf16(s0[bse + 4], s0[bse + 5]); w.w = cvt_pk_bf16(s0[bse + 6], s0[bse + 7]); }
            else { const int bse = 8 * (ks - 2); w.x = cvt_pk_bf16(s1[bse], s1[bse + 1]); w.y = cvt_pk_bf16(s1[bse + 2], s1[bse + 3]); w.z = cvt_pk_bf16(s1[bse + 4], s1[bse + 5]); w.w = cvt_pk_bf16(s1[bse + 6], s1[bse + 7]); }
            pf[ks] = __builtin_bit_cast(bf16x8, w); }
#pragma unroll
        for (int ks = 0; ks < 4; ++ks) {
            o[t][0] = __builtin_amdgcn_mfma_f32_32x32x16_bf16(vfr[0][ks], pf[ks], o[t][0], 0, 0, 0);
            o[t][1] = __builtin_amdgcn_mfma_f32_32x32x16_bf16(vfr[1][ks], pf[ks], o[t][1], 0, 0, 0);
        }
    }
}

#define LBAR() do { asm volatile("s_waitcnt lgkmcnt(0)" ::: "memory"); __builtin_amdgcn_s_barrier(); asm volatile("" ::: "memory"); } while (0)
template <int MT>
__device__ __forceinline__ void attn_unit(const Args& a, int layer, LAS unsigned char* lds, int b, int h, int qb, bool ctxq, const int wv) {
    constexpr int NSTEP = (MT == 1) ? 6 : 4;
    constexpr int KCH = NSTEP * 2;
    constexpr int NI = (MT == 3) ? 2 : 1;
    constexpr bool DEEP = (MT != 3);
    const int tid = fresh_tid(wv), lane = tid & 63, wid = wv, r32 = lane & 31, hi = lane >> 5;
    unsigned char* ws = opq_p(a.ws);
    const bf16_t* Z = (const bf16_t*)(ws + WS_Z);
    const bf16_t *Qp, *Kp, *Vp; int ldq, ldk, ldv; float scale; int grp;
    if (MT == 0) { Qp = Z + Z_NAQ + 64 * h; Kp = Z + Z_NAK + 64 * h; Vp = Z + Z_NAV + 64 * h; ldq = ldk = ldv = NZ; scale = 0.125f; grp = 0; }
    else if (MT == 1) { Qp = (const bf16_t*)(ws + WS_QM) + 96 * h; Kp = (const bf16_t*)(ws + WS_KM) + 64 * h; Vp = (const bf16_t*)(ws + WS_VM) + 64 * h; ldq = 384; ldk = 256; ldv = 256; scale = 0.10206207261596575f; grp = 1; }
    else if (MT == 2) { Qp = Z + Z_SWQ + 64 * h; Kp = Z + Z_SWK + 64 * (h >> 1); Vp = Z + Z_SWV + 64 * (h >> 1); ldq = ldk = ldv = NZ; scale = 0.125f; grp = 2; }
    else { Qp = Z + Z_DFQ + 64 * h; Kp = Z + Z_DFK + 64 * h; Vp = Z + Z_DFV + 64 * h; ldq = ldk = ldv = NZ; scale = 0.17677669529663687f; grp = 3; }
    const bf16_t* Kr = Z + Z_KR;
    const float sc2 = scale * LOG2E;
    const int qrow0 = ctxq ? NLAT + b * CTX : b * SEQ + qb * 256;
    const int myq = qrow0 + wid * 32 + r32;
    int t_lo = 0, t_hi = 31;
    if (MT == 0) { const int lo = min(max(4 * qb - 4, 0), 24), hi2 = min(max(4 * qb + 3 - 4, 0), 24) + 7; t_lo = lo; t_hi = hi2; }
    if (MT == 2) { t_lo = max(4 * qb - 2, 0); t_hi = min(4 * qb + 5, 31); }
    const int nlat = ctxq ? 0 : (t_hi - t_lo + 1), ntiles = nlat + 4;
    const int rq = 4 * qb + (wid >> 1), cq = 32 * (wid & 1) + r32, c0 = min(max(cq - 8, 0), 48), r0 = min(max(rq - 4, 0), 24);
    const int qw0 = 256 * qb + 32 * wid, qpos = qw0 + r32;
    LAS float* rpbL = (LAS float*)(lds + AL_RPB);
    if (MT == 0) { const float* rp = a.in[I_RPB] + (size_t)(layer * 4 + h) * 465; for (int i = tid; i < 465; i += 512) rpbL[i] = rp[i] * LOG2E; }
    bf16x8 qf[NSTEP];
#pragma unroll
    for (int s = 0; s < NSTEP; ++s) qf[s] = gld<bf16x8>(Qp + (size_t)myq * ldq + 16 * s + 8 * hi);
    float mrun[NI], lrun[NI]; f32x16 o[NI][2]; f32x16 negm[NI];
#pragma unroll
    for (int t = 0; t < NI; ++t) { mrun[t] = (MT == 1 || MT == 3) ? 0.f : NEGBIG; lrun[t] = 0.f; o[t][0] = f32x16{}; o[t][1] = f32x16{}; negm[t] = f32x16{}; }
    const int skey = tid / KCH, sch = tid % KCH;
    const int skey2 = ((tid & 255) + 512) / KCH, sch2 = ((tid & 255) + 512) % KCH;
    const int vkey = tid >> 3, vch = tid & 7;
    TileRegs ra, rb; ra.k2 = (u32x4){0u, 0u, 0u, 0u}; rb.k2 = ra.k2; rb.k = ra.k2; rb.v = ra.k2;
#define TILE_ROW(it) ((it) < nlat ? b * SEQ + 64 * (t_lo + (it)) : NLAT + b * CTX + 64 * ((it) - nlat))
#define LOADT(R, it) do { const int row0_ = TILE_ROW(it); \
        if (MT == 1) { R.k = sch < 8 ? gld<u32x4>(Kp + (size_t)(row0_ + skey) * ldk + sch * 8) : gld<u32x4>(Kr + (size_t)(row0_ + skey) * NZ + (sch - 8) * 8); \
            R.k2 = sch2 < 8 ? gld<u32x4>(Kp + (size_t)(row0_ + skey2) * ldk + sch2 * 8) : gld<u32x4>(Kr + (size_t)(row0_ + skey2) * NZ + (sch2 - 8) * 8); } \
        else R.k = gld<u32x4>(Kp + (size_t)(row0_ + skey) * ldk + sch * 8); \
        R.v = gld<u32x4>(Vp + (size_t)(row0_ + vkey) * ldv + vch * 8); } while (0)
#define WRITET(R, buf) do { LAS unsigned char* kb_ = lds + AL_K + (buf) * 64 * KSTR; LAS unsigned char* vb_ = lds + AL_V + (buf) * 64 * VSTR; \
        *(LAS u32x4*)(kb_ + skey * KSTR + sch * 16) = R.k; \
        if (MT == 1) { *(LAS u32x4*)(kb_ + skey2 * KSTR + sch2 * 16) = R.k2; } \
        *(LAS u32x4*)(vb_ + vkey * VSTR + vch * 16) = R.v; } while (0)
#define ACTIVE(it) (((it) >= nlat) ? true : (MT == 0 ? ((t_lo + (it)) >= r0 && (t_lo + (it)) < r0 + 8) : (MT == 2 ? ((64 * (t_lo + (it)) + 63 >= qw0 - 128) && (64 * (t_lo + (it)) <= qw0 + 31 + 128)) : true)))
#define COMPUTE(it, buf) do { if (ACTIVE(it)) attn_compute<MT, NSTEP, NI>(lds, buf, qf, mrun, lrun, o, negm, (it) == 0, (it) < nlat, t_lo + (it), r32, hi, sc2, rq, cq, c0, qpos); } while (0)
    if (DEEP) {
        const int lastt = ntiles - 1;
        LOADT(ra, 0); LOADT(rb, 1); WRITET(ra, 0); LBAR();
        for (int it = 0; it < ntiles; it += 2) {
            { const int nx = min(it + 2, lastt); LOADT(ra, nx); }
            COMPUTE(it, 0);
            if (it + 1 < ntiles) WRITET(rb, 1);
            LBAR();
            { const int nx = min(it + 3, lastt); LOADT(rb, nx); }
            if (it + 1 < ntiles) COMPUTE(it + 1, 1);
            if (it + 2 < ntiles) WRITET(ra, 0);
            LBAR();
        }
    } else {
        const int lastt = ntiles - 1;
        LOADT(ra, 0); WRITET(ra, 0); LBAR();
        for (int it = 0; it < ntiles; ++it) {
            { const int nx = min(it + 1, lastt); LOADT(ra, nx); }
            COMPUTE(it, it & 1);
            if (it + 1 < ntiles) WRITET(ra, (it + 1) & 1);
            LBAR();
        }
    }
#undef TILE_ROW
#undef LOADT
#undef WRITET
#undef ACTIVE
#undef COMPUTE
    float inv[NI];
#pragma unroll
    for (int t = 0; t < NI; ++t) {
        float l = xhalf_sum(lrun[t]);
        if (MT == 2) l += __builtin_amdgcn_exp2f(a.in[I_SINK][layer * 4 + h] * LOG2E - mrun[t]);
        inv[t] = 1.0f / l;
    }
    bf16_t* orow = (bf16_t*)(ws + WS_MIX) + (size_t)myq * DM + grp * 256 + h * 64;
    if (MT == 3) {
        const float* lamp = (const float*)(ws + WS_LAM); const float lam = lamp[2 * layer], lam_init = lamp[2 * layer + 1];
        const float w1 = inv[0], w2 = lam * inv[NI - 1];
        float ss = 0.f;
#pragma unroll
        for (int db = 0; db < 2; ++db)
#pragma unroll
            for (int r = 0; r < 16; ++r) { const float v = o[0][db][r] * w1 - o[NI - 1][db][r] * w2; o[0][db][r] = v; ss += v * v; }
        ss = xhalf_sum(ss);
        const float rs = (1.0f - lam_init) / sqrtf(ss * (1.0f / 64.0f) + EPS);
        const float* gn = a.in[I_GDIFF] + layer * 64;
#pragma unroll
        for (int db = 0; db < 2; ++db)
#pragma unroll
            for (int g4 = 0; g4 < 4; ++g4) { const int d = 32 * db + 8 * g4 + 4 * hi; const f32x4 gg = gld<f32x4>(gn + d);
                u32x2 w; w.x = cvt_pk_bf16(o[0][db][4 * g4] * rs * gg[0], o[0][db][4 * g4 + 1] * rs * gg[1]); w.y = cvt_pk_bf16(o[0][db][4 * g4 + 2] * rs * gg[2], o[0][db][4 * g4 + 3] * rs * gg[3]);
                gst<u32x2>(orow + d, w); }
    } else {
#pragma unroll
        for (int db = 0; db < 2; ++db)
#pragma unroll
            for (int p = 0; p < 2; ++p) {
                const int ga = 8 * p, gb = 8 * p + 4;
                const unsigned x0 = cvt_pk_bf16(o[0][db][ga] * inv[0], o[0][db][ga + 1] * inv[0]), x1 = cvt_pk_bf16(o[0][db][ga + 2] * inv[0], o[0][db][ga + 3] * inv[0]);
                const unsigned y0 = cvt_pk_bf16(o[0][db][gb] * inv[0], o[0][db][gb + 1] * inv[0]), y1 = cvt_pk_bf16(o[0][db][gb + 2] * inv[0], o[0][db][gb + 3] * inv[0]);
                const auto r0 = __builtin_amdgcn_permlane32_swap(x0, y0, false, false);
                const auto r1 = __builtin_amdgcn_permlane32_swap(x1, y1, false, false);
                u32x4 w; w.x = r0[0]; w.y = r1[0]; w.z = r0[1]; w.w = r1[1];
                gst<u32x4>(orow + 32 * db + 16 * p + 8 * hi, w);
            }
    }
}

template <int MT>
__device__ __forceinline__ void attn_units(const Args& a, int layer, LAS unsigned char* lds, bool need_ctx, const int wv) {
    const int G = gridDim.x;
    if (wv >= 4) __builtin_amdgcn_s_setprio(1);
    for (int u0 = blockIdx.x; u0 < 512; u0 += G) {
        int u = u0;
        if (G == 256) { const int i = u0 >> 8, c = u0 & 255, x = c & 7, j = c >> 3; u = ((i * 32 + x * 4 + (j >> 3)) << 3) | (j & 7); }
        attn_unit<MT>(a, layer, lds, u >> 5, (u >> 3) & 3, u & 7, false, wv);
    }
    if (need_ctx) {
        const int slot = MT == 3 ? 0 : MT == 1 ? 1 : MT == 0 ? 2 : 3;
        const int off = (slot * 64) % G;
        for (int v = ((int)blockIdx.x - off + G) % G; v < 64; v += G) attn_unit<MT>(a, layer, lds, v >> 2, v & 3, 0, true, wv);
    }
    __builtin_amdgcn_s_setprio(0);
}

#define XB_TMO      128
#define XB_XCNT(j)  (256  + 64 * (j))
#define XB_XSUB(j)  (1280 + 64 * (j))
#define XB_XGEN(j)  (2304 + 64 * (j))
#define XB_TOP      3328
#define XB_TOPGEN   3392
#define XCD_BAR_WORDS 3456
#define XB_SPIN_CAP (1u << 18)
__device__ __forceinline__ unsigned xb_ld(unsigned* p)              { return __hip_atomic_load(p, __ATOMIC_RELAXED, __HIP_MEMORY_SCOPE_AGENT); }
__device__ __forceinline__ unsigned xb_add(unsigned* p, unsigned v) { return __hip_atomic_fetch_add(p, v, __ATOMIC_RELAXED, __HIP_MEMORY_SCOPE_AGENT); }
__device__ __forceinline__ unsigned xb_xcc_id() { return (unsigned)__builtin_amdgcn_s_getreg((3 << 11) | 20) & 0xFu; }
#define XB_SPIN(cond, bar) do { unsigned _sp = 0; while (cond) { __builtin_amdgcn_s_sleep(1); \
    if ((++_sp & 255u) == 0u) { if (xb_ld(&(bar)[XB_TMO])) break; if (_sp > XB_SPIN_CAP) { atomicAdd(&(bar)[XB_TMO], 1u); break; } } } } while (0)
struct XcdBarrier { unsigned* bar; unsigned x; volatile LAS unsigned* st; };
__device__ __forceinline__ XcdBarrier xcd_barrier_post(unsigned* bar, volatile LAS unsigned* st, bool leader) {
    XcdBarrier b; b.bar = bar; b.x = xb_xcc_id(); b.st = st;
    if (leader) (void)xb_add(&bar[XB_XCNT(b.x)], 1u);
    return b;
}
__device__ __forceinline__ void xcd_barrier_complete(unsigned* bar, unsigned x, unsigned& nloc, unsigned& nx) {
    const unsigned G = gridDim.x * gridDim.y * gridDim.z;
    unsigned sum, cnt, mine, sp = 0u;
    for (;;) {
        sum = 0u; cnt = 0u; mine = 0u;
#pragma unroll
        for (unsigned j = 0; j < 16; ++j) { const unsigned c = xb_ld(&bar[XB_XCNT(j)]); sum += c; cnt += (c > 0u) ? 1u : 0u; mine = (j == x) ? c : mine; }
        if (sum == G) break;
        __builtin_amdgcn_s_sleep(1);
        if ((++sp & 255u) == 0u) { if (xb_ld(&bar[XB_TMO])) break; if (sp > XB_SPIN_CAP) { atomicAdd(&bar[XB_TMO], 1u); break; } }
    }
    nloc = mine > 0u ? mine : 1u; nx = cnt > 0u ? cnt : 1u;
}
__device__ __forceinline__ void xcd_barrier(const XcdBarrier& b, const int wv) {
    asm volatile("s_waitcnt vmcnt(0)" ::: "memory");
    __syncthreads();
    if (fresh_tid(wv) == 0) {
        unsigned* bar = b.bar;
        __builtin_amdgcn_s_waitcnt(0);
        unsigned nloc = b.st[0], nx = b.st[1];
        if (nloc == 0u) { xcd_barrier_complete(bar, b.x, nloc, nx); b.st[0] = nloc; b.st[1] = nx; }
        const unsigned old = xb_add(&bar[XB_XSUB(b.x)], 1u);
        const unsigned gen = old / nloc;
        if (old + 1u == (gen + 1u) * nloc) {
            __builtin_amdgcn_fence(__ATOMIC_RELEASE, "agent");
            asm volatile("s_waitcnt vmcnt(0)" ::: "memory");
            const unsigned og = xb_add(&bar[XB_TOP], 1u);
            const unsigned tg = og / nx;
            if (og + 1u == (tg + 1u) * nx) xb_add(&bar[XB_TOPGEN], 1u);
            else XB_SPIN(xb_ld(&bar[XB_TOPGEN]) == tg, bar);
            __builtin_amdgcn_fence(__ATOMIC_ACQUIRE, "agent");
            xb_add(&bar[XB_XGEN(b.x)], 1u);
            asm volatile("s_waitcnt vmcnt(0)" ::: "memory");
        } else {
            XB_SPIN(xb_ld(&bar[XB_XGEN(b.x)]) == gen, bar);
            __builtin_amdgcn_fence(__ATOMIC_ACQUIRE, "agent");
            asm volatile("s_waitcnt vmcnt(0)" ::: "memory");
        }
    }
    __syncthreads();
}

__global__ void __launch_bounds__(512, 2) fwd_kernel(Args a) {
    extern __shared__ __attribute__((aligned(16))) unsigned char lds_raw[];
    LAS unsigned char* lds = (LAS unsigned char*)lds_raw;
    cg::grid_group grid = cg::this_grid();
    const int wv = __builtin_amdgcn_readfirstlane(threadIdx.x >> 6);
    volatile LAS unsigned* bst = (volatile LAS unsigned*)(lds + LDS_BYTES - 16);
    if (fresh_tid(wv) == 0) { bst[0] = 0u; bst[1] = 0u; }
    __syncthreads();
    if (blockIdx.x == 0) { unsigned* bw = (unsigned*)(a.ws + WS_BAR); for (int i = fresh_tid(wv); i < XCD_BAR_WORDS; i += 512) bw[i] = 0u; }
    phase0(a, lds, wv);
    grid.sync();
    const XcdBarrier xbar = xcd_barrier_post((unsigned*)(a.ws + WS_BAR), bst, fresh_tid(wv) == 0);

    for (int l = 0; l < DEPTH; ++l) {
        const bool need_ctx = l < DEPTH - 1;
        const int rows_act = need_ctx ? MROWS : NLAT;
#define PH_BEGIN const int lq = opq_s(l); unsigned char* ws = opq_p(a.ws); const int G = gridDim.x, c = blockIdx.x; const float* modl = (const float*)(ws + WS_MOD) + (size_t)lq * 17 * 6144; \
        const float* xl_cur = lq == 0 ? a.in[I_X] : a.out; const float* xc_cur = lq == 0 ? a.in[I_CTX] : (const float*)(ws + WS_XC); (void)G; (void)c; (void)modl; (void)xl_cur; (void)xc_cur;
#define ROPE_TABS const float* c64 = (const float*)(ws + WS_ROPE); const float* s64 = c64 + SEQ * 32; const float* c32 = s64 + SEQ * 32; const float* s32 = c32 + SEQ * 16; (void)c64; (void)s64;
        { PH_BEGIN norm_phase(xl_cur, xc_cur, a.in[I_GATTN] + lq * DM, modl, 0, 1024, (bf16_t*)(ws + WS_H), MROWS, wv, (float*)(ws + WS_SSQ), lq > 0 ? (const bf16_t*)(ws + WS_PART) : (const bf16_t*)nullptr, modl - 17 * 6144 + 16 * 6144 + 5120, (float*)(ws + WS_XC)); }
        xcd_barrier(xbar, wv);
#ifndef NO_GZ
        { PH_BEGIN ROPE_TABS pg8::Gemm g{(const bf16_t*)(ws + WS_H), (const bf16_t*)(ws + WS_WIN) + (size_t)lq * NZ * DM, MROWS, NZ, DM, DM, DM, 0}; pg8::StaticOrder S; S.init(MROWS, NZ, G, c);
          EpiZ E{(bf16_t*)(ws + WS_Z), c64, s64, c32, s32, (float*)(ws + WS_SSQ)}; pg8::gemm_phase<EpiZ>(lds, g, S, E, wv); }
#endif
        xcd_barrier(xbar, wv);
#ifndef NO_GQ
        { PH_BEGIN ROPE_TABS pg8::Gemm g{(const bf16_t*)(ws + WS_Z) + Z_CQ, (const bf16_t*)(ws + WS_WUQ) + (size_t)lq * 512 * 256, rows_act, 512, 256, NZ, 256, 0}; pg8::StaticOrder S; S.init(rows_act, 512, G, c);
          EpiQ E{(const float*)(ws + WS_SSQ), (bf16_t*)(ws + WS_QM), c32, s32}; pg8::gemm_phase<EpiQ>(lds, g, S, E, wv); }
#endif
#ifndef NO_GKV
        { PH_BEGIN pg8::Gemm g{(const bf16_t*)(ws + WS_Z) + Z_CKV, (const bf16_t*)(ws + WS_WUKV) + (size_t)lq * 512 * 128, MROWS, 512, 128, NZ, 128, 0}; pg8::StaticOrder S; S.init(MROWS, 512, G, (c + G / 2) % G);
          EpiKV E{(const float*)(ws + WS_SSQ), (bf16_t*)(ws + WS_KM), (bf16_t*)(ws + WS_VM)}; pg8::gemm_phase<EpiKV>(lds, g, S, E, wv); }
#endif
        xcd_barrier(xbar, wv);
#ifndef NO_A3
        attn_units<3>(a, opq_s(l), lds, need_ctx, wv);
#endif
#ifndef NO_A1
        attn_units<1>(a, opq_s(l), lds, need_ctx, wv);
#endif
#ifndef NO_A0
        attn_units<0>(a, opq_s(l), lds, need_ctx, wv);
#endif
#ifndef NO_A2
        attn_units<2>(a, opq_s(l), lds, need_ctx, wv);
#endif
        xcd_barrier(xbar, wv);
#ifndef NO_GOUT
        { PH_BEGIN pg8::Gemm g{(const bf16_t*)(ws + WS_MIX), (const bf16_t*)(ws + WS_WOUT) + (size_t)lq * DM * DM, rows_act, DM, DM, DM, DM, 0}; pg8::StaticOrder S; S.init(rows_act, DM, G, c);
          EpiRes E{xl_cur, xc_cur, a.out, (float*)(ws + WS_XC), modl, 2048}; pg8::gemm_phase<EpiRes>(lds, g, S, E, wv); }
#endif
        xcd_barrier(xbar, wv);
        { PH_BEGIN norm_phase(a.out, (const float*)(ws + WS_XC), a.in[I_GMLP] + lq * DM, modl, 3072, 4096, (bf16_t*)(ws + WS_H), rows_act, wv, nullptr, nullptr, nullptr, nullptr); }
        xcd_barrier(xbar, wv);
#ifndef NO_GUP
        { PH_BEGIN pg8::Gemm g{(const bf16_t*)(ws + WS_H), (const bf16_t*)(ws + WS_WUP) + (size_t)lq * DFF * DM, rows_act, DFF, DM, DM, DM, 0}; pg8::StaticOrder S; S.init(rows_act, DFF, G, c);
          EpiUp E{(bf16_t*)(ws + WS_U)}; pg8::gemm_phase<EpiUp>(lds, g, S, E, wv); }
#endif
        xcd_barrier(xbar, wv);
#ifndef NO_GDN
        { PH_BEGIN pg8::Gemm g{(const bf16_t*)(ws + WS_U), (const bf16_t*)(ws + WS_WDOWN) + (size_t)lq * DM * DFF, NLAT, DM, DFF, DFF, DFF, 0}; pg8::StaticOrder S; S.init(NLAT, DM, G, c);
          EpiRes E{a.out, (const float*)(ws + WS_XC), a.out, (float*)(ws + WS_XC), modl, 5120}; pg8::gemm_phase<EpiRes>(lds, g, S, E, wv); }
        if (need_ctx) { PH_BEGIN pg8::Gemm g{(const bf16_t*)(ws + WS_U) + (size_t)NLAT * DFF, (const bf16_t*)(ws + WS_WDOWN) + (size_t)lq * DM * DFF, 4 * NCTX, DM, 1024, DFF, DFF, 16}; pg8::StaticOrder S; S.init(4 * NCTX, DM, G, c);
          EpiCtxSplit E{(float*)(ws + WS_XC), (bf16_t*)(ws + WS_PART), modl, 5120}; pg8::gemm_phase<EpiCtxSplit>(lds, g, S, E, wv); }
#endif
        xcd_barrier(xbar, wv);
    }
    final_norm_phase(a.out, a.in[I_GFINAL], wv);
}

extern "C" void kernel_launch(void* const* d_in, const int* in_sizes, int n_in, void* d_out, int out_size, void* d_ws, size_t ws_size, hipStream_t stream) {
    static int grid = 0;
    if (grid == 0) {
        if (n_in != 21 || out_size != NLAT * DM || ws_size < WS_END) { fprintf(stderr, "kernel_launch: unexpected shapes (n_in %d out %d ws %zu need %zu)\n", n_in, out_size, ws_size, (size_t)WS_END); grid = -1; return; }
        int dev = 0, cus = 0, per_cu = 0;
        hipGetDevice(&dev);
        hipDeviceGetAttribute(&cus, hipDeviceAttributeMultiprocessorCount, dev);
        hipFuncSetAttribute((const void*)fwd_kernel, hipFuncAttributeMaxDynamicSharedMemorySize, LDS_BYTES);
        hipOccupancyMaxActiveBlocksPerMultiprocessor(&per_cu, (const void*)fwd_kernel, 512, LDS_BYTES);
        (void)hipGetLastError();
        grid = cus;
        fprintf(stderr, "kernel_launch: cus %d per_cu %d grid %d\n", cus, per_cu, grid);
    }
    if (grid < 0) return;
    Args a{};
    for (int i = 0; i < 21; ++i) a.in[i] = (const float*)d_in[i];
    a.out = (float*)d_out; a.ws = (unsigned char*)d_ws;
    void* args[] = {&a};
    hipError_t e = hipLaunchCooperativeKernel((const void*)fwd_kernel, dim3(grid), dim3(512), args, LDS_BYTES, stream);
    if (e != hipSuccess) fprintf(stderr, "kernel_launch: cooperative launch failed: %s (grid %d)\n", hipGetErrorString(e), grid);
}
```

```cpp
#include <hip/hip_runtime.h>
#include <hip/hip_cooperative_groups.h>
#include <cstdio>
#include <cstdint>
#include <cmath>
namespace cg = cooperative_groups;

#define LAS __attribute__((address_space(3)))
#define GAS __attribute__((address_space(1)))
typedef unsigned short bf16_t;
typedef short bf16x8 __attribute__((ext_vector_type(8)));
typedef short s16x4 __attribute__((ext_vector_type(4)));
typedef float f32x4 __attribute__((ext_vector_type(4)));
typedef float f32x16 __attribute__((ext_vector_type(16)));
typedef unsigned u32x4 __attribute__((ext_vector_type(4)));
typedef unsigned u32x2 __attribute__((ext_vector_type(2)));

template <class T> __device__ __forceinline__ T gld(const void* p) { return *(const GAS T*)p; }
template <class T> __device__ __forceinline__ void gst(void* p, T v) { *(GAS T*)p = v; }
template <class T> __device__ __forceinline__ T gld_nt(const void* p) { return __builtin_nontemporal_load((const GAS T*)p); }
template <class T> __device__ __forceinline__ void gst_nt(void* p, T v) { __builtin_nontemporal_store(v, (GAS T*)p); }

constexpr int DM = 1024, NB = 16, SEQ = 2048, DEPTH = 4, CTX = 256, DFF = 4096;
constexpr int NLAT = NB * SEQ;
constexpr int NCTX = NB * CTX;
constexpr int MROWS = NLAT + NCTX;
constexpr int INC = 2400;
constexpr int NZ = 2560;
constexpr float EPS = 1e-6f;
constexpr float LOG2E = 1.4426950408889634f;
constexpr float NEGBIG = -1e30f;
constexpr int Z_NAQ = 0, Z_NAK = 256, Z_NAV = 512, Z_SWQ = 768, Z_SWK = 1024, Z_SWV = 1152, Z_DFQ = 1280, Z_DFK = 1536, Z_DFV = 1792,
              Z_CQ = 2048, Z_CKV = 2304, Z_KR = 2432;

constexpr size_t MiB = 1u << 20;
constexpr size_t WS_MOD = 0, WS_ROPE = 2 * MiB, WS_LAM = 3 * MiB, WS_WIN = 4 * MiB, WS_WOUT = 24 * MiB, WS_WUP = 32 * MiB, WS_WDOWN = 64 * MiB,
                 WS_WUQ = 96 * MiB, WS_WUKV = 97 * MiB, WS_XC = 98 * MiB, WS_H = 114 * MiB, WS_Z = 186 * MiB, WS_QM = 366 * MiB, WS_KM = 393 * MiB,
                 WS_VM = 411 * MiB, WS_MIX = 429 * MiB, WS_U = 186 * MiB, WS_END = 501 * MiB;
constexpr size_t WS_SSQ = WS_LAM + 4096;
constexpr size_t WS_PART = 474 * MiB;
constexpr size_t WS_BAR = WS_LAM + 512 * 1024;
constexpr int LDS_BYTES = 147456;

typedef float f32x2_c __attribute__((ext_vector_type(2))); typedef __bf16 bf16x2_c __attribute__((ext_vector_type(2)));
__device__ __forceinline__ unsigned cvt_pk_bf16(float lo, float hi) { f32x2_c v = {lo, hi}; bf16x2_c b = __builtin_convertvector(v, bf16x2_c); return __builtin_bit_cast(unsigned, b); }
__device__ __forceinline__ int opq_s(int x) { asm volatile("" : "+s"(x)); return x; }
__device__ __forceinline__ int opq_v(int x) { asm volatile("" : "+v"(x)); return x; }
__device__ __forceinline__ int fresh_lane() { int z = 0; asm volatile("" : "+v"(z)); return (int)__builtin_amdgcn_mbcnt_hi(~0u, __builtin_amdgcn_mbcnt_lo(~0u, (unsigned)z)); }
__device__ __forceinline__ int fresh_tid(int wv) { return wv * 64 + fresh_lane(); }
__device__ __forceinline__ unsigned char* opq_p(unsigned char* p) { asm volatile("" : "+s"(p)); return p; }
__device__ __forceinline__ float max3f(float a, float b, float c) { float r; asm("v_max3_f32 %0, %1, %2, %3" : "=v"(r) : "v"(a), "v"(b), "v"(c)); return r; }
__device__ __forceinline__ float max2f(float a, float b) { float r; asm("v_max_f32_e32 %0, %1, %2" : "=v"(r) : "v"(a), "v"(b)); return r; }
__device__ __forceinline__ float xhalf_max(float m) { auto rr = __builtin_amdgcn_permlane32_swap(__float_as_uint(m), __float_as_uint(m), false, false); return fmaxf(__uint_as_float(rr[0]), __uint_as_float(rr[1])); }
__device__ __forceinline__ float xhalf_sum(float m) { auto rr = __builtin_amdgcn_permlane32_swap(__float_as_uint(m), __float_as_uint(m), false, false); return __uint_as_float(rr[0]) + __uint_as_float(rr[1]); }
template <int X> __device__ __forceinline__ float swz_xor(float v) { return __int_as_float(__builtin_amdgcn_ds_swizzle(__float_as_int(v), (X << 10) | 0x1f)); }
__device__ __forceinline__ float bf_lo(unsigned w) { return __uint_as_float(w << 16); }
__device__ __forceinline__ float bf_hi(unsigned w) { return __uint_as_float(w & 0xffff0000u); }

namespace pg8 {
constexpr int BM = 256, BK = 64, HALF = 128, HTB = HALF * BK * 2, STAGE_BYTES = 8 * HTB, NXCD = 8, WGM = 8;
__host__ __device__ __forceinline__ int lds_byte(int r, int c) { const int st = (r >> 4) * 2 + (c >> 5), rr = r & 15, cc = c & 31, ob = rr * 64 + cc * 2; return st * 1024 + (ob ^ (((ob >> 9) & 1) << 5)); }
__host__ __device__ __forceinline__ void stage_rc(int b, int& R, int& C) { const int st = b / 1024, sb = b % 1024, swz = sb ^ (((sb >> 9) & 1) << 5); R = (st >> 1) * 16 + swz / 64; C = (st & 1) * 32 + (swz % 64) / 2; }
__host__ __device__ __forceinline__ int perm32(int rho) { const int n = rho >> 4, i = rho & 15; return 8 * (i >> 2) + 4 * n + (i & 3); }
struct Unit { int pm, pn; };
struct Gemm { const bf16_t* A; const bf16_t* Bt; int M, N, K, lda, ldb; int ks_rt; };
struct StaticOrder {
    int nM, nN, nwg, G, c;
    __device__ void init(int M, int N, int G_, int c_) { nM = M / BM; nN = N / BM; nwg = nM * nN; G = G_; c = c_; }
    __device__ bool next(int i, Unit& u) const {
        const long L = (long)i * G + c; if (L >= nwg) return false;
        int wgid = (int)L; { const int q = nwg / NXCD, r = nwg % NXCD, xcd = wgid % NXCD, off = wgid / NXCD; wgid = (xcd < r ? xcd * (q + 1) : r * (q + 1) + (xcd - r) * q) + off; }
        const int nig = WGM * nN, gid = wgid / nig, fm = gid * WGM, gsz = (nM - fm) < WGM ? (nM - fm) : WGM;
        u.pm = fm + ((wgid % nig) % gsz); u.pn = (wgid % nig) / gsz; return true;
    }
};
template <class Epi>
__device__ __forceinline__ void gemm_phase(LAS unsigned char* lds, const Gemm g, const StaticOrder& S, const Epi& E, const int wv) {
    const int tid = fresh_tid(wv), wid = wv, lane = tid & 63, wr = wid >> 2, wc = wid & 3, fr = lane & 15, fq = lane >> 4;
    const int K = opq_s(g.K), nt = K / BK;
    unsigned voffA[2], voffB[2];
#pragma unroll
    for (int i = 0; i < 2; ++i) { int R, C; stage_rc(tid * 16 + i * 8192, R, C); const int Rb = Epi::PERM ? ((R & ~31) + perm32(R & 31)) : R;
        voffA[i] = (unsigned)(R * g.lda + C) * 2u; voffB[i] = (unsigned)(Rb * g.ldb + C) * 2u; }
    const size_t kstep = (size_t)(BK * 2);
    const size_t hstepA = (size_t)HALF * g.lda * 2, hstepB = (size_t)HALF * g.ldb * 2;
    const size_t tstepA = 2 * hstepA, tstepB = 2 * hstepB;
    const unsigned ldsw = (unsigned)wid * 1024u;
    const int aoff = lds_byte(wr * 64 + fr, fq * 8), boff = lds_byte(wc * 32 + fr, fq * 8);
#define PG8_SA(b, h) (((b) * 2 + (h)) * HTB)
#define PG8_SB(b, h) ((4 + (b) * 2 + (h)) * HTB)
#define PG8_STAGE(bufoff, gbase, voff) do { _Pragma("unroll") for (int _i = 0; _i < 2; ++_i) \
        __builtin_amdgcn_global_load_lds((const unsigned*)((const char*)(gbase) + (voff)[_i]), (LAS unsigned*)(lds + (bufoff) + ldsw + _i * 8192), 16, 0, 0); } while (0)
#define PG8_LDA(dst, b, h) do { _Pragma("unroll") for (int m = 0; m < 4; ++m) _Pragma("unroll") for (int k = 0; k < 2; ++k) dst[m][k] = *(const LAS bf16x8*)(lds + PG8_SA(b, h) + aoff + m * 2048 + k * 1024); } while (0)
#define PG8_LDB(dst, b, h) do { _Pragma("unroll") for (int n = 0; n < 2; ++n) _Pragma("unroll") for (int k = 0; k < 2; ++k) dst[n][k] = *(const LAS bf16x8*)(lds + PG8_SB(b, h) + boff + n * 2048 + k * 1024); } while (0)
#define PG8_MMA(ai, bj, At, Bt) do { __builtin_amdgcn_s_setprio(1); _Pragma("unroll") for (int m = 0; m < 4; ++m) _Pragma("unroll") for (int n = 0; n < 2; ++n) _Pragma("unroll") for (int k = 0; k < 2; ++k) \
        acc[ai][bj][m][n] = __builtin_amdgcn_mfma_f32_16x16x32_bf16(Bt[n][k], At[m][k], acc[ai][bj][m][n], 0, 0, 0); __builtin_amdgcn_s_setprio(0); } while (0)
#define PG8_WAIT_V(n) asm volatile("s_waitcnt vmcnt(" #n ")" ::: "memory")
#define PG8_WAIT_L(n) asm volatile("s_waitcnt lgkmcnt(" #n ")" ::: "memory")
#define PG8_BAR __builtin_amdgcn_s_barrier()
#define PG8_SCHED __builtin_amdgcn_sched_barrier(0)
    Unit cur, nxt; int ui = 0;
    if (!S.next(0, cur)) return;
    f32x4 acc[2][2][4][2];
#pragma unroll
    for (int a = 0; a < 2; ++a)
#pragma unroll
        for (int b = 0; b < 2; ++b)
#pragma unroll
            for (int m = 0; m < 4; ++m)
#pragma unroll
                for (int n = 0; n < 2; ++n) acc[a][b][m][n] = (f32x4){0.f, 0.f, 0.f, 0.f};
    bf16x8 At[4][2], B0[2][2], B1[2][2];
#define PG8_ABASE(u) ((const char*)g.A + (g.ks_rt ? (size_t)((u).pm % g.ks_rt) * tstepA + (size_t)((u).pm / g.ks_rt) * K * 2 : (size_t)(u).pm * tstepA))
#define PG8_BBASE(u) ((const char*)g.Bt + (size_t)(u).pn * tstepB + (g.ks_rt ? (size_t)((u).pm / g.ks_rt) * K * 2 : (size_t)0))
    const char* cA = PG8_ABASE(cur); const char* cB = PG8_BBASE(cur);
    PG8_STAGE(PG8_SB(0, 0), cB, voffB); PG8_STAGE(PG8_SB(0, 1), cB + hstepB, voffB); PG8_STAGE(PG8_SA(0, 0), cA, voffA); PG8_STAGE(PG8_SA(0, 1), cA + hstepA, voffA);
    if (wr == 1) PG8_BAR;
    PG8_WAIT_V(2); PG8_BAR;
    PG8_STAGE(PG8_SB(1, 0), cB + kstep, voffB); PG8_STAGE(PG8_SA(1, 0), cA + kstep, voffA); PG8_STAGE(PG8_SB(1, 1), cB + hstepB + kstep, voffB);
    PG8_WAIT_V(6); PG8_BAR;
    for (;;) {
        const bool has_next = S.next(ui + 1, nxt);
        const char* nA = has_next ? PG8_ABASE(nxt) : cA; const char* nB = has_next ? PG8_BBASE(nxt) : cB;
        for (int t = 0; t < nt; t += 2) {
            const bool last = (t == nt - 2);
            const char* a1 = cA + (size_t)(t + 1) * kstep;
            const char* a2 = last ? nA : cA + (size_t)(t + 2) * kstep; const char* b2 = last ? nB : cB + (size_t)(t + 2) * kstep;
            const char* a3 = a2 + kstep; const char* b3 = b2 + kstep;
            PG8_LDB(B0, 0, 0); PG8_LDB(B1, 0, 1); PG8_SCHED; PG8_LDA(At, 0, 0); PG8_STAGE(PG8_SA(1, 1), a1 + hstepA, voffA);
            PG8_WAIT_V(8); PG8_WAIT_L(0); PG8_BAR; PG8_MMA(0, 0, At, B0); PG8_MMA(0, 1, At, B1); PG8_BAR; PG8_SCHED;
            PG8_LDA(At, 0, 1); PG8_STAGE(PG8_SB(0, 0), b2, voffB); PG8_STAGE(PG8_SB(0, 1), b2 + hstepB, voffB); PG8_STAGE(PG8_SA(0, 0), a2, voffA);
            PG8_WAIT_V(8); PG8_WAIT_L(0); PG8_BAR; PG8_MMA(1, 0, At, B0); PG8_MMA(1, 1, At, B1); PG8_BAR; PG8_SCHED;
            PG8_LDB(B0, 1, 0); PG8_LDB(B1, 1, 1); PG8_SCHED; PG8_LDA(At, 1, 0); PG8_STAGE(PG8_SA(0, 1), a2 + hstepA, voffA);
            PG8_WAIT_V(8); PG8_WAIT_L(0); PG8_BAR; PG8_MMA(0, 0, At, B0); PG8_MMA(0, 1, At, B1); PG8_BAR; PG8_SCHED;
            PG8_LDA(At, 1, 1); PG8_STAGE(PG8_SB(1, 0), b3, voffB); PG8_STAGE(PG8_SB(1, 1), b3 + hstepB, voffB); PG8_STAGE(PG8_SA(1, 0), a3, voffA);
            PG8_WAIT_V(8); PG8_WAIT_L(0); PG8_BAR; PG8_MMA(1, 0, At, B0); PG8_MMA(1, 1, At, B1); PG8_BAR; PG8_SCHED;
        }
        if (wr == 0) PG8_BAR;
        { const int l2 = fresh_lane(); E(acc, cur, wr, wc, l2 & 15, l2 >> 4); }
        if (!has_next) break;
#pragma unroll
        for (int a = 0; a < 2; ++a)
#pragma unroll
            for (int b = 0; b < 2; ++b)
#pragma unroll
                for (int m = 0; m < 4; ++m)
#pragma unroll
                    for (int n = 0; n < 2; ++n) acc[a][b][m][n] = (f32x4){0.f, 0.f, 0.f, 0.f};
        cur = nxt; cA = nA; cB = nB; ++ui;
        if (wr == 1) PG8_BAR;
    }
    PG8_WAIT_V(0);
    PG8_BAR;
#undef PG8_ABASE
#undef PG8_BBASE
#undef PG8_SA
#undef PG8_SB
#undef PG8_STAGE
#undef PG8_LDA
#undef PG8_LDB
#undef PG8_MMA
#undef PG8_WAIT_V
#undef PG8_WAIT_L
#undef PG8_BAR
#undef PG8_SCHED
}
}
using pg8::Unit;

struct EpiZ {
    static constexpr bool PERM = true;
    bf16_t* Z; const float* c64; const float* s64; const float* c32; const float* s32; float* ssq;
    __device__ __forceinline__ void operator()(const f32x4 (&acc)[2][2][4][2], const Unit& u, int wr, int wc, int fr, int fq) const {
        const int row0 = u.pm * 256 + wr * 64 + fr; const bool latent = u.pm < (NLAT / 256);
        if (u.pn == Z_CQ / 256 || u.pn == Z_CKV / 256) {
            const bool isq = (u.pn == Z_CQ / 256);
#pragma unroll
            for (int ai = 0; ai < 2; ++ai)
#pragma unroll
                for (int m = 0; m < 4; ++m) {
                    float ss = 0.f;
#pragma unroll
                    for (int bj = 0; bj < 2; ++bj) if (isq || bj == 0) {
                        const f32x4 a0 = acc[ai][bj][m][0], a1 = acc[ai][bj][m][1];
                        ss += (a0[0] * a0[0] + a0[1] * a0[1]) + (a0[2] * a0[2] + a0[3] * a0[3]) + (a1[0] * a1[0] + a1[1] * a1[1]) + (a1[2] * a1[2] + a1[3] * a1[3]);
                    }
                    ss += swz_xor<16>(ss); ss = xhalf_sum(ss);
                    if (fq == 0) __hip_atomic_fetch_add(ssq + (isq ? 0 : MROWS) + row0 + ai * 128 + m * 16, ss, __ATOMIC_RELAXED, __HIP_MEMORY_SCOPE_AGENT);
                }
        }
#pragma unroll
        for (int bj = 0; bj < 2; ++bj) {
            const int col0 = u.pn * 256 + bj * 128 + wc * 32 + 8 * fq;
            int mode = 0, i0 = 0;
            if (latent) {
                if (col0 >= Z_SWQ && col0 < Z_SWV) { mode = 1; i0 = (((col0 - Z_SWQ) & 63) >> 3) << 2; }
                else if ((col0 >= Z_DFQ && col0 < Z_DFV) || (col0 >= Z_KR && col0 < Z_KR + 32)) { mode = 2; i0 = ((col0 & 31) >> 3) << 2; }
            }
            const bool dfq = col0 >= Z_DFQ && col0 < Z_DFK;
            const float* ct = mode == 1 ? c64 + i0 : c32 + i0; const float* st = mode == 1 ? s64 + i0 : s32 + i0; const int tw = mode == 1 ? 32 : 16;
#pragma unroll
            for (int ai = 0; ai < 2; ++ai) {
                f32x4 cc[4], sn[4];
                if (mode) {
#pragma unroll
                    for (int m = 0; m < 4; ++m) { const int pos = (row0 + ai * 128 + m * 16) & (SEQ - 1); cc[m] = gld<f32x4>(ct + pos * tw); sn[m] = gld<f32x4>(st + pos * tw); }
                }
#pragma unroll
                for (int m = 0; m < 4; ++m) {
                    const int row = row0 + ai * 128 + m * 16;
                    f32x4 v0 = acc[ai][bj][m][0], v1 = acc[ai][bj][m][1];
                    if (dfq) { v0 = v0 * (0.17677669529663687f * LOG2E); v1 = v1 * (0.17677669529663687f * LOG2E); }
                    if (mode) { const f32x4 o0 = v0 * cc[m] - v1 * sn[m], o1 = v0 * sn[m] + v1 * cc[m]; v0 = o0; v1 = o1; }
                    u32x4 w; w.x = cvt_pk_bf16(v0[0], v0[1]); w.y = cvt_pk_bf16(v0[2], v0[3]); w.z = cvt_pk_bf16(v1[0], v1[1]); w.w = cvt_pk_bf16(v1[2], v1[3]);
                    gst<u32x4>(Z + (size_t)row * NZ + col0, w);
                }
                asm volatile("" ::: "memory");
            }
        }
    }
};
struct EpiQ {
    static constexpr bool PERM = true;
    const float* ssq; bf16_t* Qm; const float* c32; const float* s32;
    __device__ __forceinline__ void operator()(const f32x4 (&acc)[2][2][4][2], const Unit& u, int wr, int wc, int fr, int fq) const {
        const int row0 = u.pm * 256 + wr * 64 + fr; const bool latent = u.pm < (NLAT / 256);
#pragma unroll
        for (int ai = 0; ai < 2; ++ai) {
            float rstd[4];
#pragma unroll
            for (int m = 0; m < 4; ++m) rstd[m] = gld<float>(ssq + row0 + ai * 128 + m * 16);
#pragma unroll
            for (int m = 0; m < 4; ++m) rstd[m] = (0.10206207261596575f * LOG2E) / sqrtf(rstd[m] * (1.0f / 192.0f) + EPS);
#pragma unroll
            for (int bj = 0; bj < 2; ++bj) {
                const int col0 = u.pn * 256 + bj * 128 + wc * 32 + 8 * fq;
                if (col0 < 384) {
                    const int p = col0 % 96; const bool rope = latent && p >= 64; const int i0 = ((p - 64) >> 3) << 2;
                    f32x4 cc[4], sn[4];
                    if (rope) {
#pragma unroll
                        for (int m = 0; m < 4; ++m) { const int pos = (row0 + ai * 128 + m * 16) & (SEQ - 1); cc[m] = gld<f32x4>(c32 + pos * 16 + i0); sn[m] = gld<f32x4>(s32 + pos * 16 + i0); }
                    }
#pragma unroll
                    for (int m = 0; m < 4; ++m) {
                        const int row = row0 + ai * 128 + m * 16;
                        f32x4 v0 = acc[ai][bj][m][0] * rstd[m], v1 = acc[ai][bj][m][1] * rstd[m];
                        if (rope) { const f32x4 o0 = v0 * cc[m] - v1 * sn[m], o1 = v0 * sn[m] + v1 * cc[m]; v0 = o0; v1 = o1; }
                        u32x4 w; w.x = cvt_pk_bf16(v0[0], v0[1]); w.y = cvt_pk_bf16(v0[2], v0[3]); w.z = cvt_pk_bf16(v1[0], v1[1]); w.w = cvt_pk_bf16(v1[2], v1[3]);
                        gst<u32x4>(Qm + (size_t)row * 384 + col0, w);
                    }
                }
                asm volatile("" ::: "memory");
            }
        }
    }
};
struct EpiKV {
    static constexpr bool PERM = true;
    const float* ssq; bf16_t* Km; bf16_t* Vm;
    __device__ __forceinline__ void operator()(const f32x4 (&acc)[2][2][4][2], const Unit& u, int wr, int wc, int fr, int fq) const {
        const int row0 = u.pm * 256 + wr * 64 + fr;
        bf16_t* dst = u.pn == 0 ? Km : Vm;
#pragma unroll
        for (int ai = 0; ai < 2; ++ai) {
            float rstd[4];
#pragma unroll
            for (int m = 0; m < 4; ++m) rstd[m] = gld<float>(ssq + MROWS + row0 + ai * 128 + m * 16);
#pragma unroll
            for (int m = 0; m < 4; ++m) rstd[m] = 1.0f / sqrtf(rstd[m] * (1.0f / 128.0f) + EPS);
#pragma unroll
            for (int m = 0; m < 4; ++m) {
                const int row = row0 + ai * 128 + m * 16;
#pragma unroll
                for (int bj = 0; bj < 2; ++bj) {
                    const int col0 = bj * 128 + wc * 32 + 8 * fq;
                    const f32x4 v0 = acc[ai][bj][m][0] * rstd[m], v1 = acc[ai][bj][m][1] * rstd[m];
                    u32x4 w; w.x = cvt_pk_bf16(v0[0], v0[1]); w.y = cvt_pk_bf16(v0[2], v0[3]); w.z = cvt_pk_bf16(v1[0], v1[1]); w.w = cvt_pk_bf16(v1[2], v1[3]);
                    gst<u32x4>(dst + (size_t)row * 256 + col0, w);
                }
            }
            asm volatile("" ::: "memory");
        }
    }
};
struct EpiRes {
    static constexpr bool PERM = false;
    const float* xl_in; const float* xc_in; float* xl_out; float* xc_out; const float* modl; int goff;
    __device__ __forceinline__ void operator()(const f32x4 (&acc)[2][2][4][2], const Unit& u, int wr, int wc, int fr, int fq) const {
        const bool latent = u.pm < (NLAT / 256);
        const float* xin = latent ? xl_in + (size_t)u.pm * 256 * DM : xc_in + (size_t)(u.pm - NLAT / 256) * 256 * DM;
        float* xout = latent ? xl_out + (size_t)u.pm * 256 * DM : xc_out + (size_t)(u.pm - NLAT / 256) * 256 * DM;
        const float* gate = modl + (size_t)(latent ? (u.pm >> 3) : 16) * 6144 + goff;
        const int r0 = wr * 64 + fr, c0 = u.pn * 256 + wc * 32 + 4 * fq;
#pragma unroll
        for (int bj = 0; bj < 2; ++bj)
#pragma unroll
            for (int n = 0; n < 2; ++n) {
                const int col = c0 + bj * 128 + n * 16;
                const f32x4 gv = gld<f32x4>(gate + col);
                f32x4 xi[2][4];
#pragma unroll
                for (int ai = 0; ai < 2; ++ai)
#pragma unroll
                    for (int m = 0; m < 4; ++m) xi[ai][m] = gld<f32x4>(xin + (size_t)(r0 + ai * 128 + m * 16) * DM + col);
#pragma unroll
                for (int ai = 0; ai < 2; ++ai)
#pragma unroll
                    for (int m = 0; m < 4; ++m) gst<f32x4>(xout + (size_t)(r0 + ai * 128 + m * 16) * DM + col, xi[ai][m] + gv * acc[ai][bj][m][n]);
                asm volatile("" ::: "memory");
            }
    }
};
struct EpiCtxSplit {
    static constexpr bool PERM = false;
    float* xc; bf16_t* part; const float* modl; int goff;
    __device__ __forceinline__ void operator()(const f32x4 (&acc)[2][2][4][2], const Unit& u, int wr, int wc, int fr, int fq) const {
        const int kc = u.pm >> 4, rt = u.pm & 15;
        const int r0 = rt * 256 + wr * 64 + fr, c0 = u.pn * 256 + wc * 32 + 4 * fq;
        if (kc == 0) {
            const float* gate = modl + (size_t)16 * 6144 + goff;
#pragma unroll
            for (int bj = 0; bj < 2; ++bj)
#pragma unroll
                for (int n = 0; n < 2; ++n) {
                    const int col = c0 + bj * 128 + n * 16;
                    const f32x4 gv = gld<f32x4>(gate + col);
                    f32x4 xi[2][4];
#pragma unroll
                    for (int ai = 0; ai < 2; ++ai)
#pragma unroll
                        for (int m = 0; m < 4; ++m) xi[ai][m] = gld<f32x4>(xc + (size_t)(r0 + ai * 128 + m * 16) * DM + col);
#pragma unroll
                    for (int ai = 0; ai < 2; ++ai)
#pragma unroll
                        for (int m = 0; m < 4; ++m) gst<f32x4>(xc + (size_t)(r0 + ai * 128 + m * 16) * DM + col, xi[ai][m] + gv * acc[ai][bj][m][n]);
                    asm volatile("" ::: "memory");
                }
        } else {
            bf16_t* P = part + (size_t)(kc - 1) * NCTX * DM;
#pragma unroll
            for (int bj = 0; bj < 2; ++bj)
#pragma unroll
                for (int n = 0; n < 2; ++n) {
                    const int col = c0 + bj * 128 + n * 16;
#pragma unroll
                    for (int ai = 0; ai < 2; ++ai)
#pragma unroll
                        for (int m = 0; m < 4; ++m) { const f32x4 v = acc[ai][bj][m][n]; u32x2 w; w.x = cvt_pk_bf16(v[0], v[1]); w.y = cvt_pk_bf16(v[2], v[3]);
                            gst<u32x2>(P + (size_t)(r0 + ai * 128 + m * 16) * DM + col, w); }
                }
        }
    }
};
struct EpiUp {
    static constexpr bool PERM = true;
    bf16_t* U;
    __device__ __forceinline__ void operator()(const f32x4 (&acc)[2][2][4][2], const Unit& u, int wr, int wc, int fr, int fq) const {
        const int row0 = u.pm * 256 + wr * 64 + fr;
#pragma unroll
        for (int bj = 0; bj < 2; ++bj) {
            const int col0 = u.pn * 256 + bj * 128 + wc * 32 + 8 * fq;
#pragma unroll
            for (int ai = 0; ai < 2; ++ai)
#pragma unroll
                for (int m = 0; m < 4; ++m) {
                    const int row = row0 + ai * 128 + m * 16;
                    f32x4 v0 = acc[ai][bj][m][0], v1 = acc[ai][bj][m][1];
#pragma unroll
                    for (int j = 0; j < 4; ++j) { const float a = fmaxf(v0[j], 0.f), b = fmaxf(v1[j], 0.f); v0[j] = a * a; v1[j] = b * b; }
                    u32x4 w; w.x = cvt_pk_bf16(v0[0], v0[1]); w.y = cvt_pk_bf16(v0[2], v0[3]); w.z = cvt_pk_bf16(v1[0], v1[1]); w.w = cvt_pk_bf16(v1[2], v1[3]);
                    gst_nt<u32x4>(U + (size_t)row * DFF + col0, w);
                    asm volatile("" ::: "memory");
                }
        }
    }
};

struct Args { const float* in[21]; float* out; unsigned char* ws; };
enum { I_X = 0, I_C, I_CTX, I_CCTX, I_WADA, I_BADA, I_GATTN, I_WIN, I_RPB, I_GQ, I_WUQ, I_GKV, I_WUKV, I_SINK, I_LAMBDA, I_GDIFF, I_WOUT, I_GMLP, I_WUP, I_WDOWN, I_GFINAL };

__device__ __forceinline__ float wave_sum(float v) {
    v += swz_xor<1>(v); v += swz_xor<2>(v); v += swz_xor<4>(v); v += swz_xor<8>(v); v += swz_xor<16>(v);
    return xhalf_sum(v);
}

__device__ __forceinline__ int unperm64(int pp) { const int g = pp >> 3, e = pp & 7; return e < 4 ? 4 * g + e : 32 + 4 * g + (e - 4); }
__device__ __forceinline__ int unperm32(int pp) { const int g = pp >> 3, e = pp & 7; return e < 4 ? 4 * g + e : 16 + 4 * g + (e - 4); }
__device__ __forceinline__ int zmap(int n) {
    if (n < 768) return n;
    if (n < 1024) { const int p = n - 768; return 1120 + (p & ~63) + unperm64(p & 63); }
    if (n < 1152) { const int p = n - 1024; return 1376 + (p & ~63) + unperm64(p & 63); }
    if (n < 1280) return 1504 + (n - 1152);
    if (n < 1536) { const int p = n - 1280; return 1632 + (p & ~31) + unperm32(p & 31); }
    if (n < 1792) { const int p = n - 1536; return 1888 + (p & ~31) + unperm32(p & 31); }
    if (n < 2048) return 2144 + (n - 1792);
    if (n < 2304) { const int p = n - 2048; return p < 192 ? 768 + p : -1; }
    if (n < 2432) return 960 + (n - 2304);
    if (n < 2464) return 1088 + unperm32(n - 2432);
    return -1;
}
__device__ __forceinline__ int uqmap(int n) { if (n >= 384) return -1; const int hd = n / 96, p = n % 96; return hd * 96 + (p < 64 ? p : 64 + unperm32(p - 64)); }
__device__ __forceinline__ int ukvmap(int n) { if (n < 256) return (n >> 6) * 128 + (n & 63); const int q = n - 256; return (q >> 6) * 128 + 64 + (q & 63); }
template <int MODE>
__device__ __forceinline__ void transpose_item(const float* W, int ldw, int Kvalid, int Kpad, int Npad, bf16_t* WT, const float* kscale, LAS float* scr, int item, int lane) {
    const int nblk = Npad / 32, kb = item / nblk, nb = item % nblk, k0 = 64 * kb, n0 = 32 * nb;
    const int n = n0 + (lane & 31);
    const int sc = MODE == 0 ? n : MODE == 1 ? zmap(n) : MODE == 2 ? uqmap(n) : ukvmap(n);
#pragma unroll
    for (int i = 0; i < 32; ++i) { const int kk = 2 * i + (lane >> 5), k = k0 + kk; float v = 0.f;
        if (sc >= 0 && k < Kvalid) { v = W[(size_t)k * ldw + sc]; if (kscale) v *= kscale[k]; }
        scr[kk * 33 + (lane & 31)] = v; }
    asm volatile("s_waitcnt lgkmcnt(0)" ::: "memory");
    const int c = lane & 7;
#pragma unroll
    for (int j = 0; j < 4; ++j) { const int nn = (lane >> 3) + 8 * j; const LAS float* s = scr + (8 * c) * 33 + nn;
        u32x4 o; o.x = cvt_pk_bf16(s[0 * 33], s[1 * 33]); o.y = cvt_pk_bf16(s[2 * 33], s[3 * 33]); o.z = cvt_pk_bf16(s[4 * 33], s[5 * 33]); o.w = cvt_pk_bf16(s[6 * 33], s[7 * 33]);
        gst<u32x4>(WT + (size_t)(n0 + nn) * Kpad + k0 + 8 * c, o); }
    asm volatile("s_waitcnt lgkmcnt(0)" ::: "memory");
}

__device__ __forceinline__ void phase0(const Args& a, LAS unsigned char* lds, const int wv) {
    const int tid = fresh_tid(wv), lane = tid & 63, wid = wv, G = gridDim.x;
    unsigned char* ws = a.ws;
    {
        LAS float* scr = (LAS float*)(lds + wid * 16384);
        const int gw = blockIdx.x * 8 + wid, NGW = G * 8;
        constexpr int I_IN = 16 * (NZ / 32), I_OUT = 16 * 32, I_UP = 16 * 128, I_DN = 64 * 32, I_UQ = 4 * 16, I_UKV = 2 * 16;
        constexpr int PER_L = I_IN + I_OUT + I_UP + I_DN + I_UQ + I_UKV;
        for (int it = gw; it < DEPTH * PER_L; it += NGW) {
            const int l = it / PER_L; int r = it % PER_L;
            if (r < I_IN) { transpose_item<1>(a.in[I_WIN] + (size_t)l * DM * INC, INC, DM, DM, NZ, (bf16_t*)(ws + WS_WIN) + (size_t)l * NZ * DM, nullptr, scr, r, lane); continue; } r -= I_IN;
            if (r < I_OUT) { transpose_item<0>(a.in[I_WOUT] + (size_t)l * DM * DM, DM, DM, DM, DM, (bf16_t*)(ws + WS_WOUT) + (size_t)l * DM * DM, nullptr, scr, r, lane); continue; } r -= I_OUT;
            if (r < I_UP) { transpose_item<0>(a.in[I_WUP] + (size_t)l * DM * DFF, DFF, DM, DM, DFF, (bf16_t*)(ws + WS_WUP) + (size_t)l * DFF * DM, nullptr, scr, r, lane); continue; } r -= I_UP;
            if (r < I_DN) { transpose_item<0>(a.in[I_WDOWN] + (size_t)l * DFF * DM, DM, DFF, DFF, DM, (bf16_t*)(ws + WS_WDOWN) + (size_t)l * DM * DFF, nullptr, scr, r, lane); continue; } r -= I_DN;
            if (r < I_UQ) { transpose_item<2>(a.in[I_WUQ] + (size_t)l * 192 * 384, 384, 192, 256, 512, (bf16_t*)(ws + WS_WUQ) + (size_t)l * 512 * 256, a.in[I_GQ] + l * 192, scr, r, lane); continue; } r -= I_UQ;
            transpose_item<3>(a.in[I_WUKV] + (size_t)l * 128 * 512, 512, 128, 128, 512, (bf16_t*)(ws + WS_WUKV) + (size_t)l * 512 * 128, a.in[I_GKV] + l * 128, scr, r, lane);
        }
    }
    {
        float* c64 = (float*)(ws + WS_ROPE); float* s64 = c64 + SEQ * 32; float* c32 = s64 + SEQ * 32; float* s32 = c32 + SEQ * 16;
        const int gt = blockIdx.x * 512 + tid, NT = G * 512;
        for (int idx = gt; idx < SEQ * 32; idx += NT) { const int pos = idx >> 5, i = idx & 31; const int rr = pos >> 6, cc = pos & 63;
            const float f = powf(10000.0f, -(float)(i & 15) / 16.0f); const float ang = (float)(i < 16 ? rr : cc) * f; c64[idx] = cosf(ang); s64[idx] = sinf(ang); }
        for (int idx = gt; idx < SEQ * 16; idx += NT) { const int pos = idx >> 4, i = idx & 15; const int rr = pos >> 6, cc = pos & 63;
            const float f = powf(10000.0f, -(float)(i & 7) / 8.0f); const float ang = (float)(i < 8 ? rr : cc) * f; c32[idx] = cosf(ang); s32[idx] = sinf(ang); }
        if (blockIdx.x == 0 && tid < DEPTH) { const float* lp = a.in[I_LAMBDA] + tid * 128; float s1 = 0.f, s2 = 0.f;
            for (int i = 0; i < 32; ++i) { s1 += lp[i] * lp[32 + i]; s2 += lp[64 + i] * lp[96 + i]; }
            const float lam_init = 0.8f - 0.6f * expf(-0.3f * (float)tid);
            float* lamp = (float*)(ws + WS_LAM); lamp[2 * tid] = expf(s1) - expf(s2) + lam_init; lamp[2 * tid + 1] = lam_init; }
    }
    __syncthreads();
    if ((int)blockIdx.x < DEPTH * 96) {
        LAS float* act = (LAS float*)lds; LAS float* red = act + 17 * 1024;
        for (int idx = tid; idx < 17 * 1024; idx += 512) { const int i = idx >> 10, k = idx & 1023; const float v = i < 16 ? a.in[I_C][i * 1024 + k] : a.in[I_CCTX][k]; act[idx] = v / (1.0f + expf(-v)); }
        __syncthreads();
        float* mod = (float*)(ws + WS_MOD);
        for (int it = blockIdx.x; it < DEPTH * 96; it += G) {
            const int l = it / 96, j0 = (it % 96) * 64, col = tid & 63, ks = tid >> 6;
            float acc[17];
#pragma unroll
            for (int i = 0; i < 17; ++i) acc[i] = 0.f;
            const float* w = a.in[I_WADA] + ((size_t)l * 1024 + ks * 128) * 6144 + j0 + col;
            const LAS float* ak = act + ks * 128;
#pragma unroll 4
            for (int k = 0; k < 128; ++k) { const float wv = w[(size_t)k * 6144];
#pragma unroll
                for (int i = 0; i < 17; ++i) acc[i] += ak[i * 1024 + k] * wv; }
#pragma unroll
            for (int i = 0; i < 17; ++i) red[(ks * 17 + i) * 64 + col] = acc[i];
            __syncthreads();
            for (int idx = tid; idx < 17 * 64; idx += 512) { const int i = idx >> 6, cc = idx & 63; float s = 0.f;
#pragma unroll
                for (int q = 0; q < 8; ++q) s += red[(q * 17 + i) * 64 + cc];
                mod[(size_t)(l * 17 + i) * 6144 + j0 + cc] = s + a.in[I_BADA][l * 6144 + j0 + cc]; }
            __syncthreads();
        }
    }
}

__device__ __forceinline__ void norm_phase(const float* xl, const float* xc, const float* g, const float* modl, int shoff, int scoff, bf16_t* H, int nrows, const int wv, float* ssq,
                                           const bf16_t* part, const float* gate_prev, float* xc_w) {
    const int tidn = fresh_tid(wv); const int lane = tidn & 63, gw = blockIdx.x * 8 + (tidn >> 6), NGW = gridDim.x * 8;
    for (int row0 = gw; row0 < nrows; row0 += 2 * NGW) {
        f32x4 v[2][4]; float s[2] = {0.f, 0.f}; bool ok[2];
#pragma unroll
        for (int q = 0; q < 2; ++q) {
            const int row = row0 + q * NGW; ok[q] = row < nrows;
            if (ok[q]) {
                const float* src = row < NLAT ? xl + (size_t)row * DM : xc + (size_t)(row - NLAT) * DM;
#pragma unroll
                for (int j = 0; j < 4; ++j) v[q][j] = gld_nt<f32x4>(src + 4 * lane + 256 * j);
                if (ssq && lane < 2) ssq[lane * MROWS + row] = 0.f;
                if (part && row >= NLAT) {
                    const size_t ro = (size_t)(row - NLAT) * DM;
#pragma unroll
                    for (int j = 0; j < 4; ++j) { const int col = 4 * lane + 256 * j; f32x4 pa = {0.f, 0.f, 0.f, 0.f};
#pragma unroll
                        for (int c = 0; c < 3; ++c) { const u32x2 w = gld<u32x2>(part + (size_t)c * NCTX * DM + ro + col); pa[0] += bf_lo(w.x); pa[1] += bf_hi(w.x); pa[2] += bf_lo(w.y); pa[3] += bf_hi(w.y); }
                        v[q][j] += gld<f32x4>(gate_prev + col) * pa;
                        gst<f32x4>(xc_w + ro + col, v[q][j]); }
                }
            }
        }
#pragma unroll
        for (int q = 0; q < 2; ++q) if (ok[q]) {
            const int row = row0 + q * NGW;
#pragma unroll
            for (int j = 0; j < 4; ++j) s[q] += (v[q][j][0] * v[q][j][0] + v[q][j][1] * v[q][j][1]) + (v[q][j][2] * v[q][j][2] + v[q][j][3] * v[q][j][3]);
            const float rstd = 1.0f / sqrtf(wave_sum(s[q]) * (1.0f / DM) + EPS);
            const float* mr = modl + (size_t)(row < NLAT ? (row >> 11) : 16) * 6144;
#pragma unroll
            for (int j = 0; j < 4; ++j) { const int col = 4 * lane + 256 * j;
                const f32x4 gg = gld<f32x4>(g + col), sc = gld<f32x4>(mr + scoff + col), sh = gld<f32x4>(mr + shoff + col);
                const f32x4 y = (v[q][j] * rstd * gg) * (sc + 1.0f) + sh;
                u32x2 w; w.x = cvt_pk_bf16(y[0], y[1]); w.y = cvt_pk_bf16(y[2], y[3]);
                gst<u32x2>(H + (size_t)row * DM + col, w); }
        }
    }
}
__device__ __forceinline__ void final_norm_phase(float* x, const float* g, const int wv) {
    const int tidn = fresh_tid(wv); const int lane = tidn & 63, gw = blockIdx.x * 8 + (tidn >> 6), NGW = gridDim.x * 8;
    for (int row0 = gw; row0 < NLAT; row0 += 2 * NGW) {
        f32x4 v[2][4]; bool ok[2];
#pragma unroll
        for (int q = 0; q < 2; ++q) { const int row = row0 + q * NGW; ok[q] = row < NLAT;
            if (ok[q]) {
#pragma unroll
                for (int j = 0; j < 4; ++j) v[q][j] = gld<f32x4>(x + (size_t)row * DM + 4 * lane + 256 * j); } }
#pragma unroll
        for (int q = 0; q < 2; ++q) if (ok[q]) {
            float* src = x + (size_t)(row0 + q * NGW) * DM; float s = 0.f;
#pragma unroll
            for (int j = 0; j < 4; ++j) s += (v[q][j][0] * v[q][j][0] + v[q][j][1] * v[q][j][1]) + (v[q][j][2] * v[q][j][2] + v[q][j][3] * v[q][j][3]);
            const float rstd = 1.0f / sqrtf(wave_sum(s) * (1.0f / DM) + EPS);
#pragma unroll
            for (int j = 0; j < 4; ++j) { const int col = 4 * lane + 256 * j; const f32x4 gg = gld<f32x4>(g + col); gst<f32x4>(src + col, v[q][j] * rstd * gg); }
        }
    }
}

constexpr int KSTR = 208, VSTR = 192;
constexpr int AL_K = 0, AL_V = 2 * 64 * KSTR, AL_RPB = AL_V + 2 * 64 * VSTR;
__device__ __forceinline__ int crow(int r, int hi) { return (r & 3) + 8 * (r >> 2) + 4 * hi; }

constexpr float RESCALE_THR = 8.0f;
struct TileRegs { u32x4 k, k2, v; };
typedef short v4i16_t __attribute__((ext_vector_type(4)));
__device__ __forceinline__ s16x4 vtr16(const LAS unsigned char* p) { return __builtin_bit_cast(s16x4, __builtin_amdgcn_ds_read_tr16_b64_v4i16((LAS v4i16_t*)p)); }
typedef float f32x2 __attribute__((ext_vector_type(2)));


template <int MT, int NSTEP, int NI>
__device__ __forceinline__ void attn_compute(LAS unsigned char* lds, int buf, const bf16x8 (&qf)[NSTEP], float (&mrun)[NI], float (&lrun)[NI], f32x16 (&o)[NI][2], f32x16 (&negm)[NI], bool first,
                                             bool masked, int T, int r32, int hi, float sc2, int rq, int cq, int c0, int qpos) {
    const LAS unsigned char* kb = lds + AL_K + buf * 64 * KSTR; const LAS unsigned char* vb = lds + AL_V + buf * 64 * VSTR;
    const LAS float* rpbL = (const LAS float*)(lds + AL_RPB);
    bf16x8 vfr[2][4];
#pragma unroll
    for (int t = 0; t < NI; ++t) {
        constexpr int SB = (MT == 3) ? 2 : NSTEP;
        bf16x8 kf0[SB], kf1[SB];
#pragma unroll
        for (int st = 0; st < SB; ++st) {
            const int sg = (MT == 3) ? 2 * t + st : st;
            kf0[st] = *(const LAS bf16x8*)(kb + r32 * KSTR + sg * 32 + hi * 16);
            kf1[st] = *(const LAS bf16x8*)(kb + (32 + r32) * KSTR + sg * 32 + hi * 16);
        }
        if (t == 0) {
            const LAS unsigned char* vl = vb + (4 * hi + ((r32 & 15) >> 2)) * VSTR + (16 * ((r32 >> 4) & 1) + 4 * (r32 & 3)) * 2;
#pragma unroll
            for (int db = 0; db < 2; ++db) {
#pragma unroll
                for (int ks = 0; ks < 4; ++ks) {
                    const s16x4 lo = vtr16(vl + (16 * ks) * VSTR + 64 * db);
                    const s16x4 hh = vtr16(vl + (16 * ks + 8) * VSTR + 64 * db);
                    vfr[db][ks] = (bf16x8){lo[0], lo[1], lo[2], lo[3], hh[0], hh[1], hh[2], hh[3]};
                }
            }
        }
        __builtin_amdgcn_sched_barrier(0);
        constexpr bool CINIT = (MT == 1 || MT == 3);
        f32x16 s0 = f32x16{}, s1 = f32x16{};
#pragma unroll
        for (int st = 0; st < SB; ++st) {
            const int sg = (MT == 3) ? 2 * t + st : st;
            if (CINIT && st == 0) { s0 = __builtin_amdgcn_mfma_f32_32x32x16_bf16(kf0[st], qf[sg], negm[t], 0, 0, 0); s1 = __builtin_amdgcn_mfma_f32_32x32x16_bf16(kf1[st], qf[sg], negm[t], 0, 0, 0); }
            else { s0 = __builtin_amdgcn_mfma_f32_32x32x16_bf16(kf0[st], qf[sg], s0, 0, 0, 0); s1 = __builtin_amdgcn_mfma_f32_32x32x16_bf16(kf1[st], qf[sg], s1, 0, 0, 0); }
        }
        asm volatile("s_nop 15\n\ts_nop 7" : "+v"(s0), "+v"(s1));
        float mnew;
        if (CINIT) {
            float ma = max3f(s0[0], s0[1], s1[0]), mb = max3f(s0[2], s0[3], s1[1]); ma = max3f(ma, s1[2], s1[3]);
#pragma unroll
            for (int r = 4; r < 16; r += 4) { ma = max3f(ma, s0[r], s0[r + 1]); mb = max3f(mb, s0[r + 2], s0[r + 3]); ma = max3f(ma, s1[r], s1[r + 1]); mb = max3f(mb, s1[r + 2], s1[r + 3]); }
            const float mx = xhalf_max(max2f(ma, mb));
            if (first || __any(mx > RESCALE_THR)) {
                const float delta = first ? mx : fmaxf(mx, 0.f);
#pragma unroll
                for (int r = 0; r < 16; ++r) { s0[r] -= delta; s1[r] -= delta; }
                if (!first) { const float alpha = __builtin_amdgcn_exp2f(-delta); lrun[t] *= alpha;
#pragma unroll
                    for (int r = 0; r < 16; ++r) { o[t][0][r] *= alpha; o[t][1][r] *= alpha; } }
                mrun[t] += delta;
                const float nmv = -mrun[t];
#pragma unroll
                for (int r = 0; r < 16; ++r) negm[t][r] = nmv;
            }
#pragma unroll
            for (int r = 0; r < 16; ++r) { s0[r] = __builtin_amdgcn_exp2f(s0[r]); s1[r] = __builtin_amdgcn_exp2f(s1[r]); }
            mnew = mrun[t];
        } else if ((MT == 0 || MT == 2) && masked) {
            float mx = NEGBIG;
#pragma unroll
            for (int r = 0; r < 16; ++r) {
                const int k0 = crow(r, hi), k1 = 32 + k0;
                float v0 = s0[r] * sc2, v1 = s1[r] * sc2;
                if (MT == 0) {
                    const int bi = (T - rq + 7) * 31 + 15 - cq;
                    const bool ok0 = (k0 >= c0) && (k0 < c0 + 16), ok1 = (k1 >= c0) && (k1 < c0 + 16);
                    const float b0 = ok0 ? rpbL[bi + k0] : 0.f, b1 = ok1 ? rpbL[bi + k1] : 0.f;
                    v0 = ok0 ? v0 + b0 : NEGBIG; v1 = ok1 ? v1 + b1 : NEGBIG;
                } else {
                    const int d0 = 64 * T + k0 - qpos, d1 = d0 + 32;
                    v0 = (d0 >= -128 && d0 <= 128) ? v0 : NEGBIG; v1 = (d1 >= -128 && d1 <= 128) ? v1 : NEGBIG;
                }
                s0[r] = v0; s1[r] = v1; mx = fmaxf(mx, fmaxf(v0, v1));
            }
            mx = xhalf_max(mx);
            mnew = mrun[t];
            if (__any(mx > mrun[t] + RESCALE_THR)) mnew = fmaxf(mrun[t], mx);
#pragma unroll
            for (int r = 0; r < 16; ++r) { s0[r] = __builtin_amdgcn_exp2f(s0[r] - mnew); s1[r] = __builtin_amdgcn_exp2f(s1[r] - mnew); }
        } else {
            float ma = max3f(s0[0], s0[1], s1[0]), mb = max3f(s0[2], s0[3], s1[1]); ma = max3f(ma, s1[2], s1[3]);
#pragma unroll
            for (int r = 4; r < 16; r += 4) { ma = max3f(ma, s0[r], s0[r + 1]); mb = max3f(mb, s0[r + 2], s0[r + 3]); ma = max3f(ma, s1[r], s1[r + 1]); mb = max3f(mb, s1[r + 2], s1[r + 3]); }
            const float mx = xhalf_max(max2f(ma, mb));
            mnew = mrun[t];
            if (__any(mx * sc2 > mrun[t] + RESCALE_THR)) mnew = fmaxf(mrun[t], mx * sc2);
            const f32x2 nm2 = {-mnew, -mnew}, sc22 = {sc2, sc2};
#pragma unroll
            for (int r = 0; r < 16; r += 2) {
                const f32x2 e0 = (f32x2){s0[r], s0[r + 1]} * sc22 + nm2, e1 = (f32x2){s1[r], s1[r + 1]} * sc22 + nm2;
                s0[r] = __builtin_amdgcn_exp2f(e0.x); s0[r + 1] = __builtin_amdgcn_exp2f(e0.y); s1[r] = __builtin_amdgcn_exp2f(e1.x); s1[r + 1] = __builtin_amdgcn_exp2f(e1.y);
            }
        }
        f32x2 ls2 = {0.f, 0.f};
#pragma unroll
        for (int r = 0; r < 16; r += 2) { ls2 += (f32x2){s0[r], s0[r + 1]}; ls2 += (f32x2){s1[r], s1[r + 1]}; }
        const float ls = ls2.x + ls2.y;
        if (!CINIT && __any(mnew > mrun[t])) {
            const float alpha = __builtin_amdgcn_exp2f(mrun[t] - mnew);
            lrun[t] *= alpha;
#pragma unroll
            for (int r = 0; r < 16; ++r) { o[t][0][r] *= alpha; o[t][1][r] *= alpha; }
        }
        mrun[t] = mnew; lrun[t] += ls;
        bf16x8 pf[4];
#pragma unroll
        for (int ks = 0; ks < 4; ++ks) { u32x4 w;
            if (ks < 2) { const int bse = 8 * ks; w.x = cvt_pk_bf16(s0[bse], s0[bse + 1]); w.y = cvt_pk_bf16(s0[bse + 2], s0[bse + 3]); w.z = cvt_pk_bf16(s0[bse + 4], s0[bse + 5]); w.w = cvt_pk_bf16(s0[bse + 6], s0[bse + 7]); }
            else { const int bse = 8 * (ks - 2); w.x = cvt_pk_bf16(s1[bse], s1[bse + 1]); w.y = cvt_pk_bf16(s1[bse + 2], s1[bse + 3]); w.z = cvt_pk_bf16(s1[bse + 4], s1[bse + 5]); w.w = cvt_pk_bf16(s1[bse + 6], s1[bse + 7]); }
            pf[ks] = __builtin_bit_cast(bf16x8, w); }
#pragma unroll
        for (int ks = 0; ks < 4; ++ks) {
            o[t][0] = __builtin_amdgcn_mfma_f32_32x32x16_bf16(vfr[0][ks], pf[ks], o[t][0], 0, 0, 0);
            o[t][1] = __builtin_amdgcn_mfma_f32_32x32x16_bf16(vfr[1][ks], pf[ks], o[t][1], 0, 0, 0);
        }
    }
}

#define LBAR() do { asm volatile("s_waitcnt lgkmcnt(0)" ::: "memory"); __builtin_amdgcn_s_barrier(); asm volatile("" ::: "memory"); } while (0)
template <int MT>
__device__ __forceinline__ void attn_unit(const Args& a, int layer, LAS unsigned char* lds, int b, int h, int qb, bool ctxq, const int wv) {
    constexpr int NSTEP = (MT == 1) ? 6 : 4;
    constexpr int KCH = NSTEP * 2;
    constexpr int NI = (MT == 3) ? 2 : 1;
    constexpr bool DEEP = (MT != 3);
    const int tid = fresh_tid(wv), lane = tid & 63, wid = wv, r32 = lane & 31, hi = lane >> 5;
    unsigned char* ws = opq_p(a.ws);
    const bf16_t* Z = (const bf16_t*)(ws + WS_Z);
    const bf16_t *Qp, *Kp, *Vp; int ldq, ldk, ldv; float scale; int grp;
    if (MT == 0) { Qp = Z + Z_NAQ + 64 * h; Kp = Z + Z_NAK + 64 * h; Vp = Z + Z_NAV + 64 * h; ldq = ldk = ldv = NZ; scale = 0.125f; grp = 0; }
    else if (MT == 1) { Qp = (const bf16_t*)(ws + WS_QM) + 96 * h; Kp = (const bf16_t*)(ws + WS_KM) + 64 * h; Vp = (const bf16_t*)(ws + WS_VM) + 64 * h; ldq = 384; ldk = 256; ldv = 256; scale = 0.10206207261596575f; grp = 1; }
    else if (MT == 2) { Qp = Z + Z_SWQ + 64 * h; Kp = Z + Z_SWK + 64 * (h >> 1); Vp = Z + Z_SWV + 64 * (h >> 1); ldq = ldk = ldv = NZ; scale = 0.125f; grp = 2; }
    else { Qp = Z + Z_DFQ + 64 * h; Kp = Z + Z_DFK + 64 * h; Vp = Z + Z_DFV + 64 * h; ldq = ldk = ldv = NZ; scale = 0.17677669529663687f; grp = 3; }
    const bf16_t* Kr = Z + Z_KR;
    const float sc2 = scale * LOG2E;
    const int qrow0 = ctxq ? NLAT + b * CTX : b * SEQ + qb * 256;
    const int myq = qrow0 + wid * 32 + r32;
    int t_lo = 0, t_hi = 31;
    if (MT == 0) { const int lo = min(max(4 * qb - 4, 0), 24), hi2 = min(max(4 * qb + 3 - 4, 0), 24) + 7; t_lo = lo; t_hi = hi2; }
    if (MT == 2) { t_lo = max(4 * qb - 2, 0); t_hi = min(4 * qb + 5, 31); }
    const int nlat = ctxq ? 0 : (t_hi - t_lo + 1), ntiles = nlat + 4;
    const int rq = 4 * qb + (wid >> 1), cq = 32 * (wid & 1) + r32, c0 = min(max(cq - 8, 0), 48), r0 = min(max(rq - 4, 0), 24);
    const int qw0 = 256 * qb + 32 * wid, qpos = qw0 + r32;
    LAS float* rpbL = (LAS float*)(lds + AL_RPB);
    if (MT == 0) { const float* rp = a.in[I_RPB] + (size_t)(layer * 4 + h) * 465; for (int i = tid; i < 465; i += 512) rpbL[i] = rp[i] * LOG2E; }
    bf16x8 qf[NSTEP];
#pragma unroll
    for (int s = 0; s < NSTEP; ++s) qf[s] = gld<bf16x8>(Qp + (size_t)myq * ldq + 16 * s + 8 * hi);
    float mrun[NI], lrun[NI]; f32x16 o[NI][2]; f32x16 negm[NI];
#pragma unroll
    for (int t = 0; t < NI; ++t) { mrun[t] = (MT == 1 || MT == 3) ? 0.f : NEGBIG; lrun[t] = 0.f; o[t][0] = f32x16{}; o[t][1] = f32x16{}; negm[t] = f32x16{}; }
    const int skey = tid / KCH, sch = tid % KCH;
    const int skey2 = ((tid & 255) + 512) / KCH, sch2 = ((tid & 255) + 512) % KCH;
    const int vkey = tid >> 3, vch = tid & 7;
    TileRegs ra, rb; ra.k2 = (u32x4){0u, 0u, 0u, 0u}; rb.k2 = ra.k2; rb.k = ra.k2; rb.v = ra.k2;
#define TILE_ROW(it) ((it) < nlat ? b * SEQ + 64 * (t_lo + (it)) : NLAT + b * CTX + 64 * ((it) - nlat))
#define LOADT(R, it) do { const int row0_ = TILE_ROW(it); \
        if (MT == 1) { R.k = sch < 8 ? gld<u32x4>(Kp + (size_t)(row0_ + skey) * ldk + sch * 8) : gld<u32x4>(Kr + (size_t)(row0_ + skey) * NZ + (sch - 8) * 8); \
            R.k2 = sch2 < 8 ? gld<u32x4>(Kp + (size_t)(row0_ + skey2) * ldk + sch2 * 8) : gld<u32x4>(Kr + (size_t)(row0_ + skey2) * NZ + (sch2 - 8) * 8); } \
        else R.k = gld<u32x4>(Kp + (size_t)(row0_ + skey) * ldk + sch * 8); \
        R.v = gld<u32x4>(Vp + (size_t)(row0_ + vkey) * ldv + vch * 8); } while (0)
#define WRITET(R, buf) do { LAS unsigned char* kb_ = lds + AL_K + (buf) * 64 * KSTR; LAS unsigned char* vb_ = lds + AL_V + (buf) * 64 * VSTR; \
        *(LAS u32x4*)(kb_ + skey * KSTR + sch * 16) = R.k; \
        if (MT == 1) { *(LAS u32x4*)(kb_ + skey2 * KSTR + sch2 * 16) = R.k2; } \
        *(LAS u32x4*)(vb_ + vkey * VSTR + vch * 16) = R.v; } while (0)
#define ACTIVE(it) (((it) >= nlat) ? true : (MT == 0 ? ((t_lo + (it)) >= r0 && (t_lo + (it)) < r0 + 8) : (MT == 2 ? ((64 * (t_lo + (it)) + 63 >= qw0 - 128) && (64 * (t_lo + (it)) <= qw0 + 31 + 128)) : true)))
#define COMPUTE(it, buf) do { if (ACTIVE(it)) attn_compute<MT, NSTEP, NI>(lds, buf, qf, mrun, lrun, o, negm, (it) == 0, (it) < nlat, t_lo + (it), r32, hi, sc2, rq, cq, c0, qpos); } while (0)
    if (DEEP) {
        const int lastt = ntiles - 1;
        LOADT(ra, 0); LOADT(rb, 1); WRITET(ra, 0); LBAR();
        for (int it = 0; it < ntiles; it += 2) {
            { const int nx = min(it + 2, lastt); LOADT(ra, nx); }
            COMPUTE(it, 0);
            if (it + 1 < ntiles) WRITET(rb, 1);
            LBAR();
            { const int nx = min(it + 3, lastt); LOADT(rb, nx); }
            if (it + 1 < ntiles) COMPUTE(it + 1, 1);
            if (it + 2 < ntiles) WRITET(ra, 0);
            LBAR();
        }
    } else {
        const int lastt = ntiles - 1;
        LOADT(ra, 0); WRITET(ra, 0); LBAR();
        for (int it = 0; it < ntiles; ++it) {
            { const int nx = min(it + 1, lastt); LOADT(ra, nx); }
            COMPUTE(it, it & 1);
            if (it + 1 < ntiles) WRITET(ra, (it + 1) & 1);
            LBAR();
        }
    }
#undef TILE_ROW
#undef LOADT
#undef WRITET
#undef ACTIVE
#undef COMPUTE
    float inv[NI];
#pragma unroll
    for (int t = 0; t < NI; ++t) {
        float l = xhalf_sum(lrun[t]);
        if (MT == 2) l += __builtin_amdgcn_exp2f(a.in[I_SINK][layer * 4 + h] * LOG2E - mrun[t]);
        inv[t] = 1.0f / l;
    }
    bf16_t* orow = (bf16_t*)(ws + WS_MIX) + (size_t)myq * DM + grp * 256 + h * 64;
    if (MT == 3) {
        const float* lamp = (const float*)(ws + WS_LAM); const float lam = lamp[2 * layer], lam_init = lamp[2 * layer + 1];
        const float w1 = inv[0], w2 = lam * inv[NI - 1];
        float ss = 0.f;
#pragma unroll
        for (int db = 0; db < 2; ++db)
#pragma unroll
            for (int r = 0; r < 16; ++r) { const float v = o[0][db][r] * w1 - o[NI - 1][db][r] * w2; o[0][db][r] = v; ss += v * v; }
        ss = xhalf_sum(ss);
        const float rs = (1.0f - lam_init) / sqrtf(ss * (1.0f / 64.0f) + EPS);
        const float* gn = a.in[I_GDIFF] + layer * 64;
#pragma unroll
        for (int db = 0; db < 2; ++db)
#pragma unroll
            for (int p = 0; p < 2; ++p) {
                const int ga = 8 * p, gb = 8 * p + 4, da = 32 * db + 16 * p + 4 * hi, dbb = da + 8;
                const f32x4 gga = gld<f32x4>(gn + da), ggb = gld<f32x4>(gn + dbb);
                const unsigned x0 = cvt_pk_bf16(o[0][db][ga] * rs * gga[0], o[0][db][ga + 1] * rs * gga[1]), x1 = cvt_pk_bf16(o[0][db][ga + 2] * rs * gga[2], o[0][db][ga + 3] * rs * gga[3]);
                const unsigned y0 = cvt_pk_bf16(o[0][db][gb] * rs * ggb[0], o[0][db][gb + 1] * rs * ggb[1]), y1 = cvt_pk_bf16(o[0][db][gb + 2] * rs * ggb[2], o[0][db][gb + 3] * rs * ggb[3]);
                const auto r0 = __builtin_amdgcn_permlane32_swap(x0, y0, false, false);
                const auto r1 = __builtin_amdgcn_permlane32_swap(x1, y1, false, false);
                u32x4 w; w.x = r0[0]; w.y = r1[0]; w.z = r0[1]; w.w = r1[1];
                gst<u32x4>(orow + 32 * db + 16 * p + 8 * hi, w);
            }
    } else {
#pragma unroll
        for (int db = 0; db < 2; ++db)
#pragma unroll
            for (int p = 0; p < 2; ++p) {
                const int ga = 8 * p, gb = 8 * p + 4;
                const unsigned x0 = cvt_pk_bf16(o[0][db][ga] * inv[0], o[0][db][ga + 1] * inv[0]), x1 = cvt_pk_bf16(o[0][db][ga + 2] * inv[0], o[0][db][ga + 3] * inv[0]);
                const unsigned y0 = cvt_pk_bf16(o[0][db][gb] * inv[0], o[0][db][gb + 1] * inv[0]), y1 = cvt_pk_bf16(o[0][db][gb + 2] * inv[0], o[0][db][gb + 3] * inv[0]);
                const auto r0 = __builtin_amdgcn_permlane32_swap(x0, y0, false, false);
                const auto r1 = __builtin_amdgcn_permlane32_swap(x1, y1, false, false);
                u32x4 w; w.x = r0[0]; w.y = r1[0]; w.z = r0[1]; w.w = r1[1];
                gst<u32x4>(orow + 32 * db + 16 * p + 8 * hi, w);
            }
    }
}

template <int MT>
__device__ __forceinline__ void attn_units(const Args& a, int layer, LAS unsigned char* lds, bool need_ctx, const int wv) {
    const int G = gridDim.x;
    if (wv >= 4) __builtin_amdgcn_s_setprio(1);
    for (int u0 = blockIdx.x; u0 < 512; u0 += G) {
        int u = u0;
        if (G == 256) { const int i = u0 >> 8, c = u0 & 255, x = c & 7, j = c >> 3; u = ((i * 32 + x * 4 + (j >> 3)) << 3) | (j & 7); }
        attn_unit<MT>(a, layer, lds, u >> 5, (u >> 3) & 3, u & 7, false, wv);
    }
    if (need_ctx) {
        const int slot = MT == 3 ? 0 : MT == 1 ? 1 : MT == 0 ? 2 : 3;
        const int off = (slot * 64) % G;
        for (int v = ((int)blockIdx.x - off + G) % G; v < 64; v += G) attn_unit<MT>(a, layer, lds, v >> 2, v & 3, 0, true, wv);
    }
    __builtin_amdgcn_s_setprio(0);
}

#define XB_TMO      128
#define XB_XCNT(j)  (256  + 64 * (j))
#define XB_XSUB(j)  (1280 + 64 * (j))
#define XB_XGEN(j)  (2304 + 64 * (j))
#define XB_TOP      3328
#define XB_TOPGEN   3392
#define XCD_BAR_WORDS 3456
#define XB_SPIN_CAP (1u << 18)
__device__ __forceinline__ unsigned xb_ld(unsigned* p)              { return __hip_atomic_load(p, __ATOMIC_RELAXED, __HIP_MEMORY_SCOPE_AGENT); }
__device__ __forceinline__ unsigned xb_add(unsigned* p, unsigned v) { return __hip_atomic_fetch_add(p, v, __ATOMIC_RELAXED, __HIP_MEMORY_SCOPE_AGENT); }
__device__ __forceinline__ unsigned xb_xcc_id() { return (unsigned)__builtin_amdgcn_s_getreg((3 << 11) | 20) & 0xFu; }
#define XB_SPIN(cond, bar) do { unsigned _sp = 0; while (cond) { __builtin_amdgcn_s_sleep(1); \
    if ((++_sp & 255u) == 0u) { if (xb_ld(&(bar)[XB_TMO])) break; if (_sp > XB_SPIN_CAP) { atomicAdd(&(bar)[XB_TMO], 1u); break; } } } } while (0)
struct XcdBarrier { unsigned* bar; unsigned x; volatile LAS unsigned* st; };
__device__ __forceinline__ XcdBarrier xcd_barrier_post(unsigned* bar, volatile LAS unsigned* st, bool leader) {
    XcdBarrier b; b.bar = bar; b.x = xb_xcc_id(); b.st = st;
    if (leader) (void)xb_add(&bar[XB_XCNT(b.x)], 1u);
    return b;
}
__device__ __forceinline__ void xcd_barrier_complete(unsigned* bar, unsigned x, unsigned& nloc, unsigned& nx) {
    const unsigned G = gridDim.x * gridDim.y * gridDim.z;
    unsigned sum, cnt, mine, sp = 0u;
    for (;;) {
        sum = 0u; cnt = 0u; mine = 0u;
#pragma unroll
        for (unsigned j = 0; j < 16; ++j) { const unsigned c = xb_ld(&bar[XB_XCNT(j)]); sum += c; cnt += (c > 0u) ? 1u : 0u; mine = (j == x) ? c : mine; }
        if (sum == G) break;
        __builtin_amdgcn_s_sleep(1);
        if ((++sp & 255u) == 0u) { if (xb_ld(&bar[XB_TMO])) break; if (sp > XB_SPIN_CAP) { atomicAdd(&bar[XB_TMO], 1u); break; } }
    }
    nloc = mine > 0u ? mine : 1u; nx = cnt > 0u ? cnt : 1u;
}
__device__ __forceinline__ void xcd_barrier(const XcdBarrier& b, const int wv) {
    asm volatile("s_waitcnt vmcnt(0)" ::: "memory");
    __syncthreads();
    if (fresh_tid(wv) == 0) {
        unsigned* bar = b.bar;
        __builtin_amdgcn_s_waitcnt(0);
        unsigned nloc = b.st[0], nx = b.st[1];
        if (nloc == 0u) { xcd_barrier_complete(bar, b.x, nloc, nx); b.st[0] = nloc; b.st[1] = nx; }
        const unsigned old = xb_add(&bar[XB_XSUB(b.x)], 1u);
        const unsigned gen = old / nloc;
        if (old + 1u == (gen + 1u) * nloc) {
            __builtin_amdgcn_fence(__ATOMIC_RELEASE, "agent");
            asm volatile("s_waitcnt vmcnt(0)" ::: "memory");
            const unsigned og = xb_add(&bar[XB_TOP], 1u);
            const unsigned tg = og / nx;
            if (og + 1u == (tg + 1u) * nx) xb_add(&bar[XB_TOPGEN], 1u);
            else XB_SPIN(xb_ld(&bar[XB_TOPGEN]) == tg, bar);
            __builtin_amdgcn_fence(__ATOMIC_ACQUIRE, "agent");
            xb_add(&bar[XB_XGEN(b.x)], 1u);
            asm volatile("s_waitcnt vmcnt(0)" ::: "memory");
        } else {
            XB_SPIN(xb_ld(&bar[XB_XGEN(b.x)]) == gen, bar);
            __builtin_amdgcn_fence(__ATOMIC_ACQUIRE, "agent");
            asm volatile("s_waitcnt vmcnt(0)" ::: "memory");
        }
    }
    __syncthreads();
}

__global__ void __launch_bounds__(512, 2) fwd_kernel(Args a) {
    extern __shared__ __attribute__((aligned(16))) unsigned char lds_raw[];
    LAS unsigned char* lds = (LAS unsigned char*)lds_raw;
    cg::grid_group grid = cg::this_grid();
    const int wv = __builtin_amdgcn_readfirstlane(threadIdx.x >> 6);
    volatile LAS unsigned* bst = (volatile LAS unsigned*)(lds + LDS_BYTES - 16);
    if (fresh_tid(wv) == 0) { bst[0] = 0u; bst[1] = 0u; }
    __syncthreads();
    if (blockIdx.x == 0) { unsigned* bw = (unsigned*)(a.ws + WS_BAR); for (int i = fresh_tid(wv); i < XCD_BAR_WORDS; i += 512) bw[i] = 0u; }
    phase0(a, lds, wv);
    grid.sync();
    const XcdBarrier xbar = xcd_barrier_post((unsigned*)(a.ws + WS_BAR), bst, fresh_tid(wv) == 0);

    for (int l = 0; l < DEPTH; ++l) {
        const bool need_ctx = l < DEPTH - 1;
        const int rows_act = need_ctx ? MROWS : NLAT;
#define PH_BEGIN const int lq = opq_s(l); unsigned char* ws = opq_p(a.ws); const int G = gridDim.x, c = blockIdx.x; const float* modl = (const float*)(ws + WS_MOD) + (size_t)lq * 17 * 6144; \
        const float* xl_cur = lq == 0 ? a.in[I_X] : a.out; const float* xc_cur = lq == 0 ? a.in[I_CTX] : (const float*)(ws + WS_XC); (void)G; (void)c; (void)modl; (void)xl_cur; (void)xc_cur;
#define ROPE_TABS const float* c64 = (const float*)(ws + WS_ROPE); const float* s64 = c64 + SEQ * 32; const float* c32 = s64 + SEQ * 32; const float* s32 = c32 + SEQ * 16; (void)c64; (void)s64;
        { PH_BEGIN norm_phase(xl_cur, xc_cur, a.in[I_GATTN] + lq * DM, modl, 0, 1024, (bf16_t*)(ws + WS_H), MROWS, wv, (float*)(ws + WS_SSQ), lq > 0 ? (const bf16_t*)(ws + WS_PART) : (const bf16_t*)nullptr, modl - 17 * 6144 + 16 * 6144 + 5120, (float*)(ws + WS_XC)); }
        xcd_barrier(xbar, wv);
#ifndef NO_GZ
        { PH_BEGIN ROPE_TABS pg8::Gemm g{(const bf16_t*)(ws + WS_H), (const bf16_t*)(ws + WS_WIN) + (size_t)lq * NZ * DM, MROWS, NZ, DM, DM, DM, 0}; pg8::StaticOrder S; S.init(MROWS, NZ, G, c);
          EpiZ E{(bf16_t*)(ws + WS_Z), c64, s64, c32, s32, (float*)(ws + WS_SSQ)}; pg8::gemm_phase<EpiZ>(lds, g, S, E, wv); }
#endif
        xcd_barrier(xbar, wv);
#ifndef NO_GQ
        { PH_BEGIN ROPE_TABS pg8::Gemm g{(const bf16_t*)(ws + WS_Z) + Z_CQ, (const bf16_t*)(ws + WS_WUQ) + (size_t)lq * 512 * 256, rows_act, 512, 256, NZ, 256, 0}; pg8::StaticOrder S; S.init(rows_act, 512, G, c);
          EpiQ E{(const float*)(ws + WS_SSQ), (bf16_t*)(ws + WS_QM), c32, s32}; pg8::gemm_phase<EpiQ>(lds, g, S, E, wv); }
#endif
#ifndef NO_GKV
        { PH_BEGIN pg8::Gemm g{(const bf16_t*)(ws + WS_Z) + Z_CKV, (const bf16_t*)(ws + WS_WUKV) + (size_t)lq * 512 * 128, MROWS, 512, 128, NZ, 128, 0}; pg8::StaticOrder S; S.init(MROWS, 512, G, (c + G / 2) % G);
          EpiKV E{(const float*)(ws + WS_SSQ), (bf16_t*)(ws + WS_KM), (bf16_t*)(ws + WS_VM)}; pg8::gemm_phase<EpiKV>(lds, g, S, E, wv); }
#endif
        xcd_barrier(xbar, wv);
#ifndef NO_A3
        attn_units<3>(a, opq_s(l), lds, need_ctx, wv);
#endif
#ifndef NO_A1
        attn_units<1>(a, opq_s(l), lds, need_ctx, wv);
#endif
#ifndef NO_A0
        attn_units<0>(a, opq_s(l), lds, need_ctx, wv);
#endif
#ifndef NO_A2
        attn_units<2>(a, opq_s(l), lds, need_ctx, wv);
#endif
        xcd_barrier(xbar, wv);
#ifndef NO_GOUT
        { PH_BEGIN pg8::Gemm g{(const bf16_t*)(ws + WS_MIX), (const bf16_t*)(ws + WS_WOUT) + (size_t)lq * DM * DM, rows_act, DM, DM, DM, DM, 0}; pg8::StaticOrder S; S.init(rows_act, DM, G, c);
          EpiRes E{xl_cur, xc_cur, a.out, (float*)(ws + WS_XC), modl, 2048}; pg8::gemm_phase<EpiRes>(lds, g, S, E, wv); }
#endif
        xcd_barrier(xbar, wv);
        { PH_BEGIN norm_phase(a.out, (const float*)(ws + WS_XC), a.in[I_GMLP] + lq * DM, modl, 3072, 4096, (bf16_t*)(ws + WS_H), rows_act, wv, nullptr, nullptr, nullptr, nullptr); }
        xcd_barrier(xbar, wv);
#ifndef NO_GUP
        { PH_BEGIN pg8::Gemm g{(const bf16_t*)(ws + WS_H), (const bf16_t*)(ws + WS_WUP) + (size_t)lq * DFF * DM, rows_act, DFF, DM, DM, DM, 0}; pg8::StaticOrder S; S.init(rows_act, DFF, G, c);
          EpiUp E{(bf16_t*)(ws + WS_U)}; pg8::gemm_phase<EpiUp>(lds, g, S, E, wv); }
#endif
        xcd_barrier(xbar, wv);
#ifndef NO_GDN
        { PH_BEGIN pg8::Gemm g{(const bf16_t*)(ws + WS_U), (const bf16_t*)(ws + WS_WDOWN) + (size_t)lq * DM * DFF, NLAT, DM, DFF, DFF, DFF, 0}; pg8::StaticOrder S; S.init(NLAT, DM, G, c);
          EpiRes E{a.out, (const float*)(ws + WS_XC), a.out, (float*)(ws + WS_XC), modl, 5120}; pg8::gemm_phase<EpiRes>(lds, g, S, E, wv); }
        if (need_ctx) { PH_BEGIN pg8::Gemm g{(const bf16_t*)(ws + WS_U) + (size_t)NLAT * DFF, (const bf16_t*)(ws + WS_WDOWN) + (size_t)lq * DM * DFF, 4 * NCTX, DM, 1024, DFF, DFF, 16}; pg8::StaticOrder S; S.init(4 * NCTX, DM, G, c);
          EpiCtxSplit E{(float*)(ws + WS_XC), (bf16_t*)(ws + WS_PART), modl, 5120}; pg8::gemm_phase<EpiCtxSplit>(lds, g, S, E, wv); }
#endif
        xcd_barrier(xbar, wv);
    }
    final_norm_phase(a.out, a.in[I_GFINAL], wv);
}

extern "C" void kernel_launch(void* const* d_in, const int* in_sizes, int n_in, void* d_out, int out_size, void* d_ws, size_t ws_size, hipStream_t stream) {
    static int grid = 0;
    if (grid == 0) {
        if (n_in != 21 || out_size != NLAT * DM || ws_size < WS_END) { fprintf(stderr, "kernel_launch: unexpected shapes (n_in %d out %d ws %zu need %zu)\n", n_in, out_size, ws_size, (size_t)WS_END); grid = -1; return; }
        int dev = 0, cus = 0, per_cu = 0;
        hipGetDevice(&dev);
        hipDeviceGetAttribute(&cus, hipDeviceAttributeMultiprocessorCount, dev);
        hipFuncSetAttribute((const void*)fwd_kernel, hipFuncAttributeMaxDynamicSharedMemorySize, LDS_BYTES);
        hipOccupancyMaxActiveBlocksPerMultiprocessor(&per_cu, (const void*)fwd_kernel, 512, LDS_BYTES);
        (void)hipGetLastError();
        grid = cus;
        fprintf(stderr, "kernel_launch: cus %d per_cu %d grid %d\n", cus, per_cu, grid);
    }
    if (grid < 0) return;
    Args a{};
    for (int i = 0; i < 21; ++i) a.in[i] = (const float*)d_in[i];
    a.out = (float*)d_out; a.ws = (unsigned char*)d_ws;
    void* args[] = {&a};
    hipError_t e = hipLaunchCooperativeKernel((const void*)fwd_kernel, dim3(grid), dim3(512), args, LDS_BYTES, stream);
    if (e != hipSuccess) fprintf(stderr, "kernel_launch: cooperative launch failed: %s (grid %d)\n", hipGetErrorString(e), grid);
}
```
